# Optimizing an MI355X kernel written in HIP

```python
import jax, jax.numpy as jnp
from jax import lax
import numpy as np

D_MODEL = 2048
BATCH = 2
SEQ = 16384
DEPTH = 1

D_A = 1024
CHUNK = 128
N_GROUPS_A = 8
GROUP_W_A = D_A // N_GROUPS_A
D_B = 1024
HEAD_B = 64
N_HEADS_B = D_B // HEAD_B
DECAY_LORA = 64
AAA_LORA = 64
GATE_LORA = 160
D_FF = 5632
CONV_W = 3
RMS_EPS = 1e-6
LN_EPS = 1e-5
GN_EPS = 64e-5
D_B_IN = 3 * D_B + DECAY_LORA + AAA_LORA + GATE_LORA
D_IN = 2 * D_A + D_B_IN + 2 * D_MODEL

kernel_name = 'hybrid_gmlp_rwkv7_gated_block'


def rmsnorm(x, g):
    x32 = x.astype(jnp.float32)
    y = x32 * lax.rsqrt(jnp.mean(x32 * x32, axis=-1, keepdims=True) + RMS_EPS)
    return (y * g.astype(jnp.float32)).astype(x.dtype)


def layernorm(x, w, b):
    x32 = x.astype(jnp.float32)
    mu = jnp.mean(x32, axis=-1, keepdims=True)
    var = jnp.mean(jnp.square(x32 - mu), axis=-1, keepdims=True)
    y = (x32 - mu) * lax.rsqrt(var + LN_EPS)
    return (y * w.astype(jnp.float32) + b.astype(jnp.float32)).astype(x.dtype)


def token_shift(x):
    return jnp.pad(x[:, :-1], ((0, 0), (1, 0), (0, 0)))


def causal_dwconv(x, w, b):
    S = x.shape[1]
    xp = jnp.pad(x, ((0, 0), (CONV_W - 1, 0), (0, 0)))
    y = b
    for j in range(CONV_W):
        y = y + w[j] * xp[:, j:j + S]
    return y


def gmlp_spatial_gating(u, v, ln_w, ln_b, ws, bs):
    Bsz, S, _ = v.shape
    n_chunks = S // CHUNK
    v = layernorm(v, ln_w, ln_b)
    vc = v.reshape(Bsz, n_chunks, CHUNK, N_GROUPS_A, GROUP_W_A)
    causal = jnp.tril(jnp.ones((CHUNK, CHUNK), dtype=bool))
    wm = jnp.where(causal[None], ws, jnp.zeros_like(ws))
    mixed = jnp.einsum('gts,bnsgc->bntgc', wm, vc) + bs.T[None, None, :, :, None]
    return u * mixed.reshape(Bsz, S, D_A)


def wkv7_scan(r, decay, k, v, a_vec, b_vec):
    Bsz = r.shape[0]

    def step(state, inp):
        r_t, w_t, k_t, v_t, a_t, b_t = inp
        sa = jnp.einsum('bhvk,bhk->bhv', state, a_t)
        state = (state * w_t[:, :, None, :]
                 + sa[..., None] * b_t[:, :, None, :]
                 + v_t[..., None] * k_t[:, :, None, :])
        y_t = jnp.einsum('bhvk,bhk->bhv', state, r_t)
        return state, y_t

    xs = tuple(jnp.moveaxis(t, 1, 0) for t in (r, decay, k, v, a_vec, b_vec))
    s0 = jnp.zeros((Bsz, N_HEADS_B, HEAD_B, HEAD_B), jnp.float32)
    _, ys = lax.scan(step, s0, xs)
    return jnp.moveaxis(ys, 0, 1)


def rwkv7_time_mix(feat, mu, w0, w2, a0, a2, g2, k_k, k_a, r_k, ln_w, ln_b):
    f32 = jnp.float32
    Bsz, S, _ = feat.shape
    feat = feat + (token_shift(feat) - feat) * mu
    r, k, v, wlo, alo, glo = jnp.split(
        feat, [D_B, 2 * D_B, 3 * D_B, 3 * D_B + DECAY_LORA, 3 * D_B + DECAY_LORA + AAA_LORA], axis=-1)
    w = -jax.nn.softplus(-(w0 + jnp.tanh(wlo) @ w2).astype(f32)) - 0.5
    decay = jnp.exp(-jnp.exp(w))
    a = jax.nn.sigmoid(a0 + alo @ a2)
    g = jax.nn.sigmoid(glo) @ g2

    def heads(t):
        return t.reshape(Bsz, S, N_HEADS_B, HEAD_B)

    kk = heads(k * k_k).astype(f32)
    kk = kk / jnp.maximum(jnp.sqrt(jnp.sum(kk * kk, axis=-1, keepdims=True)), 1e-12)
    k = k * (1.0 + (a - 1.0) * k_a)
    rh, kh, vh, ah = heads(r).astype(f32), heads(k).astype(f32), heads(v).astype(f32), heads(a).astype(f32)
    y = wkv7_scan(rh, heads(decay), kh, vh, -kk, kk * ah)
    mean = jnp.mean(y, axis=-1, keepdims=True)
    var = jnp.mean(jnp.square(y - mean), axis=-1, keepdims=True)
    y = ((y - mean) * lax.rsqrt(var + GN_EPS)).reshape(Bsz, S, D_B)
    y = y * ln_w.astype(f32) + ln_b.astype(f32)
    bonus = jnp.sum(rh * kh * r_k.astype(f32), axis=-1, keepdims=True) * vh
    y = y + bonus.reshape(Bsz, S, D_B)
    return (y * g.astype(f32)).astype(feat.dtype)


def setup_inputs(seed: int = 0) -> dict:
    key = jax.random.key(seed)
    ks = jax.random.split(key, 32)
    f32 = jnp.float32
    L = DEPTH

    def nrm(k, shape, scale):
        return jax.random.normal(k, shape, f32) * scale

    return {
        'x': nrm(ks[0], (BATCH, SEQ, D_MODEL), 1.0),
        'norm1_g': 1.0 + nrm(ks[1], (L, D_MODEL), 0.02),
        'w_in': nrm(ks[2], (L, D_MODEL, D_IN), D_MODEL ** -0.5),
        'mu_b': jax.random.uniform(ks[3], (L, D_B_IN), f32),
        'rwkv_w0': jax.random.uniform(ks[4], (L, D_B), f32, -5.0, 1.0),
        'rwkv_w2': nrm(ks[5], (L, DECAY_LORA, D_B), 0.1 * DECAY_LORA ** -0.5),
        'rwkv_a0': nrm(ks[6], (L, D_B), 0.5),
        'rwkv_a2': nrm(ks[7], (L, AAA_LORA, D_B), AAA_LORA ** -0.5),
        'rwkv_g2': nrm(ks[8], (L, GATE_LORA, D_B), GATE_LORA ** -0.5),
        'rwkv_kk': 0.85 + nrm(ks[9], (L, D_B), 0.05),
        'rwkv_ka': 1.0 + nrm(ks[10], (L, D_B), 0.05),
        'rwkv_rk': nrm(ks[11], (L, N_HEADS_B, HEAD_B), 0.1),
        'rwkv_ln_w': 1.0 + nrm(ks[12], (L, D_B), 0.02),
        'rwkv_ln_b': nrm(ks[13], (L, D_B), 0.02),
        'gmlp_ln_w': 1.0 + nrm(ks[14], (L, D_A), 0.02),
        'gmlp_ln_b': nrm(ks[15], (L, D_A), 0.02),
        'gmlp_ws': nrm(ks[16], (L, N_GROUPS_A, CHUNK, CHUNK), CHUNK ** -0.5),
        'gmlp_bs': 1.0 + nrm(ks[17], (L, N_GROUPS_A, CHUNK), 0.1),
        'w_proj_a': nrm(ks[18], (L, D_A, D_MODEL), D_A ** -0.5),
        'w_proj_b': nrm(ks[19], (L, D_B, D_MODEL), D_B ** -0.5),
        'w_out': nrm(ks[20], (L, D_MODEL, D_MODEL), D_MODEL ** -0.5),
        'norm2_g': 1.0 + nrm(ks[21], (L, D_MODEL), 0.02),
        'w_up': nrm(ks[22], (L, D_MODEL, 2 * D_FF), D_MODEL ** -0.5),
        'conv_w': nrm(ks[23], (L, CONV_W, 2 * D_FF), CONV_W ** -0.5),
        'conv_b': nrm(ks[24], (L, 2 * D_FF), 0.02),
        'w_down': nrm(ks[25], (L, D_FF, D_MODEL), D_FF ** -0.5),
        'norm_f_g': 1.0 + nrm(ks[26], (D_MODEL,), 0.02),
    }


def reference(x, norm1_g, w_in, mu_b, rwkv_w0, rwkv_w2, rwkv_a0, rwkv_a2, rwkv_g2, rwkv_kk, rwkv_ka,
              rwkv_rk, rwkv_ln_w, rwkv_ln_b, gmlp_ln_w, gmlp_ln_b, gmlp_ws, gmlp_bs, w_proj_a, w_proj_b,
              w_out, norm2_g, w_up, conv_w, conv_b, w_down, norm_f_g):
    for l in range(DEPTH):
        h = rmsnorm(x, norm1_g[l])
        proj = h @ w_in[l]
        a_u, a_v, feat_b, gate_a, gate_b = jnp.split(
            proj, [D_A, 2 * D_A, 2 * D_A + D_B_IN, 2 * D_A + D_B_IN + D_MODEL], axis=-1)
        y_a = gmlp_spatial_gating(jax.nn.gelu(a_u, approximate=False), jax.nn.gelu(a_v, approximate=False),
                                  gmlp_ln_w[l], gmlp_ln_b[l], gmlp_ws[l], gmlp_bs[l])
        y_b = rwkv7_time_mix(feat_b, mu_b[l], rwkv_w0[l], rwkv_w2[l], rwkv_a0[l], rwkv_a2[l], rwkv_g2[l],
                             rwkv_kk[l], rwkv_ka[l], rwkv_rk[l], rwkv_ln_w[l], rwkv_ln_b[l])
        merged = (jax.nn.sigmoid(gate_a) * (y_a @ w_proj_a[l])
                  + jax.nn.sigmoid(gate_b) * (y_b @ w_proj_b[l]))
        x = x + merged @ w_out[l]
        h = rmsnorm(x, norm2_g[l])
        up = causal_dwconv(h @ w_up[l], conv_w[l], conv_b[l])
        u_g, u_v = jnp.split(up, 2, axis=-1)
        x = x + (jax.nn.gelu(u_g, approximate=False) * u_v) @ w_down[l]
    return rmsnorm(x, norm_f_g)
```

```cpp
#include <hip/hip_runtime.h>
#include <cstdio>
#include <cstdint>
namespace pg8 {
#define PG8_LAS __attribute__((address_space(3)))
typedef unsigned short bf16_t;
typedef short bf16x8 __attribute__((ext_vector_type(8)));
typedef float f32x4 __attribute__((ext_vector_type(4)));
typedef unsigned u32x4 __attribute__((ext_vector_type(4)));
constexpr int BM = 256, BK = 64, HALF = 128, HTB = HALF * BK * 2  , STAGE_BYTES = 8 * HTB, NXCD = 8, WGM = 8;

__host__ __device__ __forceinline__ int lds_byte(int r, int c) { const int st = (r >> 4) * 2 + (c >> 5), rr = r & 15, cc = c & 31, ob = rr * 64 + cc * 2; return st * 1024 + (ob ^ (((ob >> 9) & 1) << 5)); }
__host__ __device__ __forceinline__ void stage_rc(int b, int& R, int& C) { const int st = b / 1024, sb = b % 1024, swz = sb ^ (((sb >> 9) & 1) << 5); R = (st >> 1) * 16 + swz / 64; C = (st & 1) * 32 + (swz % 64) / 2; }
__host__ __device__ __forceinline__ int perm32(int rho) { const int n = rho >> 4, i = rho & 15; return 8 * (i >> 2) + 4 * n + (i & 3); }

struct Unit { int pm, pn; };
struct Gemm { const bf16_t* A; const bf16_t* Bt; int M, N, K; };

struct StaticOrder {
    int nM, nN, nwg, G, c;
    __host__ __device__ void init(int M, int N, int G_, int c_) { nM = M / BM; nN = N / BM; nwg = nM * nN; G = G_; c = c_; }
    __host__ __device__ bool next(int i, Unit& u) const {
        const long L = (long)i * G + c; if (L >= nwg) return false;
        int wgid = (int)L; { const int q = nwg / NXCD, r = nwg % NXCD, xcd = wgid % NXCD, off = wgid / NXCD; wgid = (xcd < r ? xcd * (q + 1) : r * (q + 1) + (xcd - r) * q) + off; }
        const int nig = WGM * nN, gid = wgid / nig, fm = gid * WGM, gsz = (nM - fm) < WGM ? (nM - fm) : WGM;
        u.pm = fm + ((wgid % nig) % gsz); u.pn = (wgid % nig) / gsz; return true;
    }
    __device__ __forceinline__ void a_ready(const Unit&) const {}
    __device__ __forceinline__ void done(const Unit&) const {}
};

typedef float cvt_f32x2_t __attribute__((ext_vector_type(2))); typedef __bf16 cvt_bf16x2_t __attribute__((ext_vector_type(2)));
__device__ __forceinline__ unsigned cvt_pk_bf16(float lo, float hi) { const cvt_f32x2_t v = {lo, hi}; const cvt_bf16x2_t b = __builtin_convertvector(v, cvt_bf16x2_t); return __builtin_bit_cast(unsigned, b); }
typedef float f32x2 __attribute__((ext_vector_type(2)));
__device__ __forceinline__ f32x2 gelu_pk(f32x2 v) {
    const f32x2 av = __builtin_elementwise_abs(v), d = av * 0.2316418882f + 1.0f;
    f32x2 t; t.x = __builtin_amdgcn_rcpf(d.x); t.y = __builtin_amdgcn_rcpf(d.y);
    f32x2 q = t * 0.5307027145f + (-0.7265760135f); q = q * t + 0.7107068705f; q = q * t + (-0.142248368f); q = q * t + 0.127414796f; q = q * t;
    const f32x2 s = (v * v) * (-0.72134752044f);
    f32x2 e; e.x = __builtin_amdgcn_exp2f(s.x); e.y = __builtin_amdgcn_exp2f(s.y);
    const f32x2 m = v * (q * e), r = v - m;
    f32x2 o; o.x = v.x < 0.f ? m.x : r.x; o.y = v.y < 0.f ? m.y : r.y; return o;
}

template <int ACT  > struct EpiBf16 {
    static constexpr bool PERM = true, AFTER_DRAIN = false; static_assert(ACT == 0 || ACT == 1, "EpiBf16: ACT is 0 (none) or 1 (gelu_pk)");
    bf16_t* O; int ldc; const float* bias; int split_cols; size_t split_stride; float scale0;
    __device__ __forceinline__ void operator()(const f32x4 (&acc)[2][2][4][2], const Unit& u, int wr, int wc, int fr, int fq) const {
        const int row0 = u.pm * BM + wr * 64 + fr; int colt = u.pn * BM; bf16_t* base = O;
        float sc = 1.f; if (split_cols) { const int t = colt / split_cols; base += (size_t)t * split_stride; colt -= t * split_cols; if (t == 0) sc = scale0; }
        const int col0 = colt + wc * 32 + 8 * fq, bcol0 = u.pn * BM + wc * 32 + 8 * fq;
        f32x4 bv[2][2];
#pragma unroll
        for (int bj = 0; bj < 2; ++bj)
#pragma unroll
            for (int n = 0; n < 2; ++n) bv[bj][n] = bias ? *(const f32x4*)(bias + bcol0 + bj * HALF + 4 * n) : (f32x4){0.f, 0.f, 0.f, 0.f};
#pragma unroll
        for (int ai = 0; ai < 2; ++ai)
#pragma unroll
            for (int m = 0; m < 4; ++m) { bf16_t* rowp = base + (size_t)(row0 + ai * HALF + m * 16) * ldc + col0;
#pragma unroll
                for (int bj = 0; bj < 2; ++bj) { f32x4 v0 = acc[ai][bj][m][0] + bv[bj][0], v1 = acc[ai][bj][m][1] + bv[bj][1];
                    if (ACT == 1) { f32x2 a = gelu_pk((f32x2){v0[0], v0[1]}), b = gelu_pk((f32x2){v0[2], v0[3]}), c = gelu_pk((f32x2){v1[0], v1[1]}), d = gelu_pk((f32x2){v1[2], v1[3]});
                        v0 = (f32x4){a.x, a.y, b.x, b.y}; v1 = (f32x4){c.x, c.y, d.x, d.y}; }
                    v0 = v0 * sc; v1 = v1 * sc; u32x4 w; w.x = cvt_pk_bf16(v0[0], v0[1]); w.y = cvt_pk_bf16(v0[2], v0[3]); w.z = cvt_pk_bf16(v1[0], v1[1]); w.w = cvt_pk_bf16(v1[2], v1[3]);
                    *(u32x4*)(rowp + bj * HALF) = w; } }
    }
};

__device__ __forceinline__ float sigm(float x) { return __builtin_amdgcn_rcpf(1.0f + __expf(-x)); }
__device__ __forceinline__ float bf2f(unsigned short h) { return __uint_as_float(((unsigned)h) << 16); }
__device__ __forceinline__ u32x4 pack8(f32x4 v0, f32x4 v1) { u32x4 w; w.x = cvt_pk_bf16(v0[0], v0[1]); w.y = cvt_pk_bf16(v0[2], v0[3]); w.z = cvt_pk_bf16(v1[0], v1[1]); w.w = cvt_pk_bf16(v1[2], v1[3]); return w; }
__device__ __forceinline__ void unpack8(u32x4 w, f32x4& v0, f32x4& v1) {
    v0[0] = __uint_as_float(w.x << 16); v0[1] = __uint_as_float(w.x & 0xffff0000u); v0[2] = __uint_as_float(w.y << 16); v0[3] = __uint_as_float(w.y & 0xffff0000u);
    v1[0] = __uint_as_float(w.z << 16); v1[1] = __uint_as_float(w.z & 0xffff0000u); v1[2] = __uint_as_float(w.w << 16); v1[3] = __uint_as_float(w.w & 0xffff0000u); }
__device__ __forceinline__ f32x4 gelu4(f32x4 v) { f32x2 a = gelu_pk((f32x2){v[0], v[1]}), b = gelu_pk((f32x2){v[2], v[3]}); return (f32x4){a.x, a.y, b.x, b.y}; }

struct EpiIn {
    static constexpr bool PERM = true, AFTER_DRAIN = false;
    bf16_t *AU, *AV, *FEAT, *LRAW; const float* rstd; float* lns;
    __device__ __forceinline__ void operator()(f32x4 (&acc)[2][2][4][2], const Unit& u, int wr, int wc, int fr_, int fq_) const {
        int fr = fr_, fq = fq_; asm volatile("" : "+v"(fr), "+v"(fq));
        const int pn = u.pn; bf16_t* base; int ld, ct; bool act;
        if (pn < 4) { base = AU; ld = 1024; ct = pn; act = true; } else if (pn < 8) { base = AV; ld = 1024; ct = pn - 4; act = true; }
        else if (pn < 20) { base = FEAT; ld = 3072; ct = pn - 8; act = false; } else { base = LRAW; ld = 512; ct = pn - 20; act = false; }
        const int row0 = u.pm * BM + wr * 64 + fr, col0 = ct * BM + wc * 32 + 8 * fq;
#pragma unroll
        for (int ai = 0; ai < 2; ++ai)
#pragma unroll
            for (int m = 0; m < 4; ++m) { const int row = row0 + ai * HALF + m * 16; const float rs = rstd[row]; bf16_t* rowp = base + (size_t)row * ld + col0;
                float s1 = 0.f, s2 = 0.f;
#pragma unroll
                for (int bj = 0; bj < 2; ++bj) { f32x4 v0 = acc[ai][bj][m][0] * rs, v1 = acc[ai][bj][m][1] * rs;
                    if (act) { v0 = gelu4(v0); v1 = gelu4(v1); }
                    s1 += ((v0[0] + v0[1]) + (v0[2] + v0[3])) + ((v1[0] + v1[1]) + (v1[2] + v1[3]));
                    s2 += ((v0[0] * v0[0] + v0[1] * v0[1]) + (v0[2] * v0[2] + v0[3] * v0[3])) + ((v1[0] * v1[0] + v1[1] * v1[1]) + (v1[2] * v1[2] + v1[3] * v1[3]));
                    *(u32x4*)(rowp + bj * HALF) = pack8(v0, v1); }
                if (pn >= 4 && pn < 8) { s1 += __shfl_xor(s1, 16); s1 += __shfl_xor(s1, 32); s2 += __shfl_xor(s2, 16); s2 += __shfl_xor(s2, 32);
                    if (fq == 0) { lns[(size_t)row * 32 + (pn - 4) * 4 + wc] = s1; lns[(size_t)row * 32 + 16 + (pn - 4) * 4 + wc] = s2; } } }
    }
};
struct EpiGate {
    static constexpr bool PERM = true, AFTER_DRAIN = false;
    bf16_t* GAB; const float* rstd;
    __device__ __forceinline__ void operator()(f32x4 (&acc)[2][2][4][2], const Unit& u, int wr, int wc, int fr_, int fq_) const {
        int fr = fr_, fq = fq_; asm volatile("" : "+v"(fr), "+v"(fq));
        const int row0 = u.pm * BM + wr * 64 + fr, col0 = u.pn * BM + wc * 32 + 8 * fq;
#pragma unroll
        for (int ai = 0; ai < 2; ++ai)
#pragma unroll
            for (int m = 0; m < 4; ++m) { const int row = row0 + ai * HALF + m * 16; const float rs = rstd[row]; bf16_t* rowp = GAB + (size_t)row * 4096 + col0;
#pragma unroll
                for (int bj = 0; bj < 2; ++bj) { f32x4 v0 = acc[ai][bj][m][0] * rs, v1 = acc[ai][bj][m][1] * rs;
#pragma unroll
                    for (int i = 0; i < 4; ++i) { v0[i] = sigm(v0[i]); v1[i] = sigm(v1[i]); }
                    *(u32x4*)(rowp + bj * HALF) = pack8(v0, v1); } }
    }
};
struct EpiLora {
    static constexpr bool PERM = true, AFTER_DRAIN = false;
    float* DEC; bf16_t* AS; bf16_t* G; const float* w0; const float* a0;
    __device__ __forceinline__ void operator()(f32x4 (&acc)[2][2][4][2], const Unit& u, int wr, int wc, int fr_, int fq_) const {
        int fr = fr_, fq = fq_; asm volatile("" : "+v"(fr), "+v"(fq));
        const int pn = u.pn, kind = pn >> 2, ct = pn & 3;
        const int row0 = u.pm * BM + wr * 64 + fr, col0 = ct * BM + wc * 32 + 8 * fq;
        if (kind == 2) {
#pragma unroll
            for (int ai = 0; ai < 2; ++ai)
#pragma unroll
                for (int m = 0; m < 4; ++m) { bf16_t* rowp = G + (size_t)(row0 + ai * HALF + m * 16) * 1024 + col0;
#pragma unroll
                    for (int bj = 0; bj < 2; ++bj) *(u32x4*)(rowp + bj * HALF) = pack8(acc[ai][bj][m][0], acc[ai][bj][m][1]); }
        } else {
            const float* bias = kind == 0 ? w0 : a0;
#pragma unroll
            for (int bj = 0; bj < 2; ++bj) {
                const f32x4 b0 = *(const f32x4*)(bias + col0 + bj * HALF), b1 = *(const f32x4*)(bias + col0 + bj * HALF + 4);
#pragma unroll
                for (int ai = 0; ai < 2; ++ai)
#pragma unroll
                    for (int m = 0; m < 4; ++m) { const size_t off = (size_t)(row0 + ai * HALF + m * 16) * 1024 + col0 + bj * HALF;
                        f32x4 v0 = acc[ai][bj][m][0] + b0, v1 = acc[ai][bj][m][1] + b1;
                        if (kind == 0) {
#pragma unroll
                            for (int i = 0; i < 4; ++i) { float z = -v0[i]; float sp = fmaxf(z, 0.f) + __logf(1.0f + __expf(-fabsf(z))); v0[i] = __expf(-__expf(-sp - 0.5f));
                                                          z = -v1[i]; sp = fmaxf(z, 0.f) + __logf(1.0f + __expf(-fabsf(z))); v1[i] = __expf(-__expf(-sp - 0.5f)); }
                            *(f32x4*)(DEC + off) = v0; *(f32x4*)(DEC + off + 4) = v1;
                        } else {
#pragma unroll
                            for (int i = 0; i < 4; ++i) { v0[i] = sigm(v0[i]); v1[i] = sigm(v1[i]); }
                            *(u32x4*)(AS + off) = pack8(v0, v1);
                        }
                        }
            }
        }
    }
};
struct EpiPlain {
    static constexpr bool PERM = true, AFTER_DRAIN = false;
    bf16_t* O;
    __device__ __forceinline__ void operator()(f32x4 (&acc)[2][2][4][2], const Unit& u, int wr, int wc, int fr_, int fq_) const {
        int fr = fr_, fq = fq_; asm volatile("" : "+v"(fr), "+v"(fq));
        const int row0 = u.pm * BM + wr * 64 + fr, col0 = u.pn * BM + wc * 32 + 8 * fq;
#pragma unroll
        for (int ai = 0; ai < 2; ++ai)
#pragma unroll
            for (int m = 0; m < 4; ++m) { bf16_t* rowp = O + (size_t)(row0 + ai * HALF + m * 16) * 2048 + col0;
#pragma unroll
                for (int bj = 0; bj < 2; ++bj) *(u32x4*)(rowp + bj * HALF) = pack8(acc[ai][bj][m][0], acc[ai][bj][m][1]); }
    }
};
struct EpiMerge {
    static constexpr bool PERM = true, AFTER_DRAIN = false;
    const bf16_t* GAB; const bf16_t* PA; bf16_t* O;
    __device__ __forceinline__ void operator()(f32x4 (&acc)[2][2][4][2], const Unit& u, int wr, int wc, int fr_, int fq_) const {
        int fr = fr_, fq = fq_; asm volatile("" : "+v"(fr), "+v"(fq));
        const int row0 = u.pm * BM + wr * 64 + fr, col0 = u.pn * BM + wc * 32 + 8 * fq;
#pragma unroll
        for (int ai = 0; ai < 2; ++ai)
#pragma unroll
            for (int m = 0; m < 4; ++m) { const int row = row0 + ai * HALF + m * 16;
#pragma unroll
                for (int bj = 0; bj < 2; ++bj) { const int c = col0 + bj * HALF;
                    f32x4 ga0, ga1, gb0, gb1, p0, p1;
                    unpack8(*(const u32x4*)(GAB + (size_t)row * 4096 + c), ga0, ga1); unpack8(*(const u32x4*)(GAB + (size_t)row * 4096 + 2048 + c), gb0, gb1);
                    unpack8(*(const u32x4*)(PA + (size_t)row * 2048 + c), p0, p1);
                    const f32x4 o0 = ga0 * p0 + gb0 * acc[ai][bj][m][0], o1 = ga1 * p1 + gb1 * acc[ai][bj][m][1];
                    *(u32x4*)(O + (size_t)row * 2048 + c) = pack8(o0, o1); } }
    }
};
template <bool OUTF> struct EpiRes {
    static constexpr bool PERM = true, AFTER_DRAIN = false;
    const bf16_t* base; float* out; bf16_t* ob; float* ssq;
    __device__ __forceinline__ void operator()(f32x4 (&acc)[2][2][4][2], const Unit& u, int wr, int wc, int fr_, int fq_) const {
        int fr = fr_, fq = fq_; asm volatile("" : "+v"(fr), "+v"(fq));
        const int row0 = u.pm * BM + wr * 64 + fr, col0 = u.pn * BM + wc * 32 + 8 * fq;
#pragma unroll
        for (int ai = 0; ai < 2; ++ai)
#pragma unroll
            for (int m = 0; m < 4; ++m) { const int row = row0 + ai * HALF + m * 16; float s = 0.f;
#pragma unroll
                for (int bj = 0; bj < 2; ++bj) { const size_t off = (size_t)row * 2048 + col0 + bj * HALF;
                    f32x4 b0, b1; unpack8(*(const u32x4*)(base + off), b0, b1);
                    const f32x4 x0 = b0 + acc[ai][bj][m][0], x1 = b1 + acc[ai][bj][m][1];
                    if (OUTF) { *(f32x4*)(out + off) = x0; *(f32x4*)(out + off + 4) = x1; }
                    else *(u32x4*)(ob + off) = pack8(x0, x1);
                    s += (x0[0] * x0[0] + x0[1] * x0[1]) + (x0[2] * x0[2] + x0[3] * x0[3]) + (x1[0] * x1[0] + x1[1] * x1[1]) + (x1[2] * x1[2] + x1[3] * x1[3]); }
                s += __shfl_xor(s, 16); s += __shfl_xor(s, 32);
                if (fq == 0) ssq[(size_t)row * 32 + u.pn * 4 + wc] = s; }
    }
};
__device__ __forceinline__ float dpp_ror1(float x) { float r; asm volatile("s_nop 1\n\tv_mov_b32_dpp %0, %1 row_ror:1 row_mask:0xf bank_mask:0xf" : "=&v"(r) : "v"(x)); return r; }
__device__ __forceinline__ float dpp_ror2(float x) { float r; asm volatile("s_nop 1\n\tv_mov_b32_dpp %0, %1 row_ror:2 row_mask:0xf bank_mask:0xf" : "=&v"(r) : "v"(x)); return r; }
struct EpiUp {
    static constexpr bool PERM = true, AFTER_DRAIN = false;
    bf16_t* ACT; const float* ssq1; const float* cw; const float* cb; float* TOP; float* BOT; PG8_LAS unsigned char* el;
    __device__ __forceinline__ void operator()(f32x4 (&acc)[2][2][4][2], const Unit& u, int wr, int wc, int fr_, int fq_) const {
        int fr = fr_, fq = fq_; asm volatile("" : "+v"(fr), "+v"(fq));
        PG8_LAS float* rsL = (PG8_LAS float*)el; PG8_LAS float* hal = (PG8_LAS float*)(el + 1024);
        const int tid = threadIdx.x;
        if (tid < 256) { const f32x4* p = (const f32x4*)(ssq1 + (size_t)(u.pm * BM + tid) * 32); f32x4 s = p[0];
#pragma unroll
            for (int i = 1; i < 8; ++i) s += p[i];
            rsL[tid] = 1.0f / sqrtf(((s[0] + s[1]) + (s[2] + s[3])) * (1.0f / 2048.0f) + 1e-6f); }
        if (fr >= 14) {
#pragma unroll
            for (int ai = 0; ai < 2; ++ai)
#pragma unroll
                for (int bj = 0; bj < 2; ++bj)
#pragma unroll
                    for (int n = 0; n < 2; ++n) *(PG8_LAS f32x4*)(hal + ((2 * ai + wr) * 2 + (fr - 14)) * 256 + bj * HALF + wc * 32 + 8 * fq + 4 * n) = acc[ai][bj][3][n];
        }
        asm volatile("s_waitcnt lgkmcnt(0)" ::: "memory"); __builtin_amdgcn_s_barrier(); asm volatile("" ::: "memory");
        const int jcol = u.pn * HALF + wc * 32 + 8 * fq;
        if (wr == 1 && fr >= 14) { const float rsb = rsL[240 + fr];
#pragma unroll
            for (int bj = 0; bj < 2; ++bj)
#pragma unroll
                for (int n = 0; n < 2; ++n) *(f32x4*)(BOT + ((size_t)u.pm * 2 + (fr - 14)) * 11264 + u.pn * BM + bj * HALF + wc * 32 + 8 * fq + 4 * n) = acc[1][bj][3][n] * rsb; }
#pragma unroll
        for (int ai = 0; ai < 2; ++ai) {
            const int blk = 2 * ai + wr;
            float rsr[4];
#pragma unroll
            for (int m = 0; m < 4; ++m) rsr[m] = rsL[blk * 64 + m * 16 + fr];
            const float rs14 = blk ? rsL[blk * 64 - 2] : 0.f, rs15 = blk ? rsL[blk * 64 - 1] : 0.f;
#pragma unroll
            for (int bj = 0; bj < 2; ++bj)
#pragma unroll
                for (int n = 0; n < 2; ++n) {
                    const int ct = bj * HALF + wc * 32 + 8 * fq + 4 * n;
                    const int cidx = bj * 5632 + jcol + 4 * n;
                    const f32x4 w0 = *(const f32x4*)(cw + cidx), w1 = *(const f32x4*)(cw + 11264 + cidx), w2 = *(const f32x4*)(cw + 22528 + cidx), b4 = *(const f32x4*)(cb + cidx);
                    f32x4 pR1 = (f32x4){0.f, 0.f, 0.f, 0.f}, pR2 = pR1;
                    if (blk) { const f32x4 h14 = *(const PG8_LAS f32x4*)(hal + ((blk - 1) * 2 + 0) * 256 + ct) * rs14, h15 = *(const PG8_LAS f32x4*)(hal + ((blk - 1) * 2 + 1) * 256 + ct) * rs15;
                        pR1 = h15; pR2 = (fr == 0) ? h14 : h15; }
#pragma unroll
                    for (int m = 0; m < 4; ++m) {
                        const f32x4 U = acc[ai][bj][m][n] * rsr[m];
                        f32x4 R1, R2;
#pragma unroll
                        for (int i = 0; i < 4; ++i) { R1[i] = dpp_ror1(U[i]); R2[i] = dpp_ror2(U[i]); }
                        const f32x4 U1 = (fr >= 1) ? R1 : pR1, U2 = (fr >= 2) ? R2 : pR2;
                        const f32x4 C = b4 + w0 * U2 + w1 * U1 + w2 * U;
                        acc[ai][bj][m][n] = C; pR1 = R1; pR2 = R2;
                        asm volatile("" : "+v"(acc[ai][bj][m][n]));
                    }

                }
            if (ai == 0 && wr == 0 && fr < 2) {
#pragma unroll
                for (int bj = 0; bj < 2; ++bj)
#pragma unroll
                    for (int n = 0; n < 2; ++n) *(f32x4*)(TOP + ((size_t)u.pm * 2 + fr) * 11264 + u.pn * BM + bj * HALF + wc * 32 + 8 * fq + 4 * n) = acc[0][bj][0][n]; }
#pragma unroll
            for (int m = 0; m < 4; ++m) { const int row = u.pm * BM + blk * 64 + m * 16 + fr;
                const f32x4 g0 = gelu4(acc[ai][0][m][0]), g1 = gelu4(acc[ai][0][m][1]);
                *(u32x4*)(ACT + (size_t)row * 5632 + jcol) = pack8(g0 * acc[ai][1][m][0], g1 * acc[ai][1][m][1]); }
        }
    }
};
template <class Epi, class Sched, bool ALIGN_EPI = false, bool SP2 = false>
__device__ __forceinline__ void gemm_phase(PG8_LAS unsigned char* lds, const Gemm g, const Sched& S, const Epi& E) {
    const int tid = threadIdx.x, wid = __builtin_amdgcn_readfirstlane(tid >> 6), lane = tid & 63, wr = wid >> 2, wc = wid & 3, fr = lane & 15, fq = lane >> 4;
    const int K = g.K, nt = K / BK;
    unsigned voffA[2], voffB[2];
#pragma unroll
    for (int i = 0; i < 2; ++i) { int R, C; stage_rc(tid * 16 + i * 8192, R, C); const int Rb = Epi::PERM ? ((R & ~31) + perm32(R & 31)) : R;
        voffA[i] = (unsigned)(R * K + C) * 2u; voffB[i] = (unsigned)(Rb * K + C) * 2u; }
    const size_t kstep = (size_t)(BK * 2);
    const size_t hstep = (size_t)HALF * K * 2;
    const size_t tstep = 2 * hstep;
    const unsigned ldsw = (unsigned)wid * 1024u;
    const int aoff = lds_byte(wr * 64 + fr, fq * 8), boff = lds_byte(wc * 32 + fr, fq * 8);
#define PG8_SA(b, h) (((b) * 2 + (h)) * HTB)
#define PG8_SB(b, h) ((4 + (b) * 2 + (h)) * HTB)
#define PG8_STAGE(bufoff, gbase, voff) do { _Pragma("unroll") for (int _i = 0; _i < 2; ++_i) \
        __builtin_amdgcn_global_load_lds((const unsigned*)((const char*)(gbase) + (voff)[_i]), (PG8_LAS unsigned*)(lds + (bufoff) + ldsw + _i * 8192), 16, 0, 0); } while (0)
#define PG8_LDA(dst, b, h) do { _Pragma("unroll") for (int m = 0; m < 4; ++m) _Pragma("unroll") for (int k = 0; k < 2; ++k) dst[m][k] = *(const PG8_LAS bf16x8*)(lds + PG8_SA(b, h) + aoff + m * 2048 + k * 1024); } while (0)
#define PG8_LDB(dst, b, h) do { _Pragma("unroll") for (int n = 0; n < 2; ++n) _Pragma("unroll") for (int k = 0; k < 2; ++k) dst[n][k] = *(const PG8_LAS bf16x8*)(lds + PG8_SB(b, h) + boff + n * 2048 + k * 1024); } while (0)
#define PG8_MMA(ai, bj, At, Bt) do { __builtin_amdgcn_s_setprio(1); _Pragma("unroll") for (int m = 0; m < 4; ++m) _Pragma("unroll") for (int n = 0; n < 2; ++n) _Pragma("unroll") for (int k = 0; k < 2; ++k) \
        acc[ai][bj][m][n] = __builtin_amdgcn_mfma_f32_16x16x32_bf16(Bt[n][k], At[m][k], acc[ai][bj][m][n], 0, 0, 0); __builtin_amdgcn_s_setprio(0); } while (0)
#define PG8_WAIT_V(n) asm volatile("s_waitcnt vmcnt(" #n ")" ::: "memory")
#define PG8_WAIT_L(n) asm volatile("s_waitcnt lgkmcnt(" #n ")" ::: "memory")
#define PG8_BAR __builtin_amdgcn_s_barrier()
#define PG8_SCHED __builtin_amdgcn_sched_barrier(0)
    Unit cur, nxt; int ui = 0;
    if (!S.next(0, cur)) return;
    f32x4 acc[2][2][4][2];
#pragma unroll
    for (int a = 0; a < 2; ++a)
#pragma unroll
        for (int b = 0; b < 2; ++b)
#pragma unroll
            for (int m = 0; m < 4; ++m)
#pragma unroll
                for (int n = 0; n < 2; ++n) acc[a][b][m][n] = (f32x4){0.f, 0.f, 0.f, 0.f};
    bf16x8 At[4][2], B0[2][2], B1[2][2];
    const char* cA = (const char*)g.A + (size_t)cur.pm * tstep; const char* cB = (const char*)g.Bt + (size_t)cur.pn * tstep;
    S.a_ready(cur);
    if constexpr (SP2) {
        PG8_STAGE(PG8_SB(0, 0), cB, voffB); PG8_STAGE(PG8_SB(0, 1), cB + hstep, voffB); PG8_STAGE(PG8_SA(0, 0), cA, voffA); PG8_STAGE(PG8_SA(0, 1), cA + hstep, voffA);
        if (wr == 1) PG8_BAR;
        PG8_WAIT_V(2); PG8_BAR;
        PG8_STAGE(PG8_SB(1, 0), cB + kstep, voffB); PG8_STAGE(PG8_SA(1, 0), cA + kstep, voffA); PG8_STAGE(PG8_SB(1, 1), cB + hstep + kstep, voffB);
        PG8_WAIT_V(6); PG8_BAR;
    } else {
        PG8_STAGE(PG8_SB(0, 0), cB, voffB); PG8_STAGE(PG8_SA(0, 0), cA, voffA); PG8_STAGE(PG8_SB(0, 1), cB + hstep, voffB); PG8_STAGE(PG8_SA(0, 1), cA + hstep, voffA);
        if (wr == 1) PG8_BAR;
        PG8_WAIT_V(4); PG8_BAR;
        PG8_STAGE(PG8_SB(1, 0), cB + kstep, voffB); PG8_STAGE(PG8_SA(1, 0), cA + kstep, voffA); PG8_STAGE(PG8_SB(1, 1), cB + hstep + kstep, voffB);
        PG8_WAIT_V(6); PG8_BAR;
    }
    for (;;) {
        const bool has_next = S.next(ui + 1, nxt);
        const char* nA = has_next ? (const char*)g.A + (size_t)nxt.pm * tstep : cA; const char* nB = has_next ? (const char*)g.Bt + (size_t)nxt.pn * tstep : cB;
        for (int t = 0; t < nt; t += 2) {
            const bool last = (t == nt - 2);
            const char* a1 = cA + (size_t)(t + 1) * kstep;
            const char* a2 = last ? nA : cA + (size_t)(t + 2) * kstep; const char* b2 = last ? nB : cB + (size_t)(t + 2) * kstep;
            const char* a3 = a2 + kstep; const char* b3 = b2 + kstep;
            if (last && has_next) S.a_ready(nxt);
            if constexpr (SP2) {
            PG8_LDB(B0, 0, 0); PG8_LDB(B1, 0, 1); PG8_SCHED; PG8_LDA(At, 0, 0); PG8_STAGE(PG8_SA(1, 1), a1 + hstep, voffA);
            PG8_WAIT_V(8); PG8_WAIT_L(0); PG8_BAR; PG8_MMA(0, 0, At, B0); PG8_MMA(0, 1, At, B1); PG8_BAR; PG8_SCHED;
            PG8_LDA(At, 0, 1); PG8_STAGE(PG8_SB(0, 0), b2, voffB); PG8_STAGE(PG8_SB(0, 1), b2 + hstep, voffB); PG8_STAGE(PG8_SA(0, 0), a2, voffA);
            PG8_WAIT_V(8); PG8_WAIT_L(0); PG8_BAR; PG8_MMA(1, 0, At, B0); PG8_MMA(1, 1, At, B1); PG8_BAR; PG8_SCHED;
            PG8_LDB(B0, 1, 0); PG8_LDB(B1, 1, 1); PG8_SCHED; PG8_LDA(At, 1, 0); PG8_STAGE(PG8_SA(0, 1), a2 + hstep, voffA);
            PG8_WAIT_V(8); PG8_WAIT_L(0); PG8_BAR; PG8_MMA(0, 0, At, B0); PG8_MMA(0, 1, At, B1); PG8_BAR; PG8_SCHED;
            PG8_LDA(At, 1, 1); PG8_STAGE(PG8_SB(1, 0), b3, voffB); PG8_STAGE(PG8_SB(1, 1), b3 + hstep, voffB); PG8_STAGE(PG8_SA(1, 0), a3, voffA);
            PG8_WAIT_V(8); PG8_WAIT_L(0); PG8_BAR; PG8_MMA(1, 0, At, B0); PG8_MMA(1, 1, At, B1); PG8_BAR; PG8_SCHED;
            } else {
            PG8_LDB(B0, 0, 0); PG8_SCHED; PG8_LDA(At, 0, 0); PG8_STAGE(PG8_SA(1, 1), a1 + hstep, voffA);
            PG8_WAIT_L(8); PG8_BAR; PG8_WAIT_L(0); PG8_MMA(0, 0, At, B0); PG8_BAR; PG8_SCHED;
            PG8_LDB(B1, 0, 1); PG8_STAGE(PG8_SB(0, 0), b2, voffB);
            PG8_BAR; PG8_WAIT_L(0); PG8_MMA(0, 1, At, B1); PG8_BAR;
            PG8_LDA(At, 0, 1); PG8_STAGE(PG8_SA(0, 0), a2, voffA);
            PG8_BAR; PG8_WAIT_L(0); PG8_MMA(1, 0, At, B0); PG8_BAR; PG8_SCHED;
            PG8_STAGE(PG8_SB(0, 1), b2 + hstep, voffB);
            PG8_WAIT_V(6); PG8_BAR; PG8_MMA(1, 1, At, B1); PG8_BAR;
            PG8_LDB(B0, 1, 0); PG8_SCHED; PG8_LDA(At, 1, 0); PG8_STAGE(PG8_SA(0, 1), a2 + hstep, voffA);
            PG8_WAIT_L(8); PG8_BAR; PG8_WAIT_L(0); PG8_MMA(0, 0, At, B0); PG8_BAR; PG8_SCHED;
            PG8_LDB(B1, 1, 1); PG8_STAGE(PG8_SB(1, 0), b3, voffB);
            PG8_BAR; PG8_WAIT_L(0); PG8_MMA(0, 1, At, B1); PG8_BAR;
            PG8_LDA(At, 1, 1); PG8_STAGE(PG8_SA(1, 0), a3, voffA);
            PG8_BAR; PG8_WAIT_L(0); PG8_MMA(1, 0, At, B0); PG8_BAR; PG8_SCHED;
            PG8_STAGE(PG8_SB(1, 1), b3 + hstep, voffB);
            PG8_WAIT_V(6); PG8_BAR; PG8_MMA(1, 1, At, B1); PG8_BAR;
            }
        }
        if constexpr (ALIGN_EPI) { if (wr == 0) PG8_BAR; }
        if constexpr (!Epi::AFTER_DRAIN) { E(acc, cur, wr, wc, fr, fq); S.done(cur); }
        if (!has_next) break;
#pragma unroll
        for (int a = 0; a < 2; ++a)
#pragma unroll
            for (int b = 0; b < 2; ++b)
#pragma unroll
                for (int m = 0; m < 4; ++m)
#pragma unroll
                    for (int n = 0; n < 2; ++n) acc[a][b][m][n] = (f32x4){0.f, 0.f, 0.f, 0.f};
        cur = nxt; cA = nA; cB = nB; ++ui;
        if constexpr (ALIGN_EPI) { if (wr == 1) PG8_BAR; }
    }
    PG8_WAIT_V(0);
    if constexpr (!ALIGN_EPI) { if (wr == 0) PG8_BAR; }
    PG8_BAR;
    if constexpr (Epi::AFTER_DRAIN) { E.fused(acc, cur, wr, wc, fr, fq, lds, wid, lane); S.done(cur); }
#undef PG8_SA
#undef PG8_SB
#undef PG8_STAGE
#undef PG8_LDA
#undef PG8_LDB
#undef PG8_MMA
#undef PG8_WAIT_V
#undef PG8_WAIT_L
#undef PG8_BAR
#undef PG8_SCHED
}
}

#include <hip/hip_cooperative_groups.h>
namespace cg = cooperative_groups;
#define LAS __attribute__((address_space(3)))
typedef unsigned short bf16;
typedef float f32x4 __attribute__((ext_vector_type(4)));
typedef float f32x2 __attribute__((ext_vector_type(2)));
typedef short bf16x8 __attribute__((ext_vector_type(8)));
typedef unsigned u32x4 __attribute__((ext_vector_type(4)));
typedef unsigned u32x2 __attribute__((ext_vector_type(2)));

constexpr int T = 32768, SEQ = 16384, DM = 2048, DA = 1024, DB = 1024, NH = 16, DFF = 5632;
constexpr int N_IN1 = 5632, N_GATE = 4096, N_LORA = 3072, K_LORA = 384;
constexpr int NCH = 64, CL = SEQ / NCH;
constexpr int NWAVES = 8, NTHR = 512;
constexpr int LDS_BYTES = 147456, EPI_OFF = 131072 + 1024;
constexpr size_t MiB = 1u << 20;
constexpr size_t WS_W_IN = 0, WS_W_LORA = 38 * MiB, WS_W_PA = 41 * MiB, WS_W_PB = 45 * MiB, WS_W_OUT = 49 * MiB, WS_W_UP = 57 * MiB, WS_W_DOWN = 101 * MiB;
constexpr size_t WS_BAR = 135 * MiB, BAR_BYTES = 16384;
constexpr size_t WS_RSTD1 = 124 * MiB, WS_SSQ1 = 125 * MiB, WS_SSQ2 = 129 * MiB, WS_BONUS = 133 * MiB;
constexpr size_t WS_XB = 136 * MiB;
constexpr size_t WS_AU = 264 * MiB, WS_AV = 328 * MiB;
constexpr size_t WS_DEC = WS_AU, WS_MERGED = WS_AU;
constexpr size_t WS_FEAT = 392 * MiB;
constexpr size_t WS_PA = WS_FEAT, WS_ACT = WS_FEAT;
constexpr size_t WS_LRAW = 584 * MiB, WS_LIN = 616 * MiB;
constexpr size_t WS_AS = 640 * MiB, WS_ST = 896 * MiB;
constexpr size_t WS_G = 704 * MiB, WS_YA = 768 * MiB, WS_YB = 832 * MiB, WS_B = 896 * MiB;
constexpr size_t WS_TOP = 960 * MiB, WS_BOT = 971 * MiB, WS_END = 982 * MiB;

struct Params {
    const float* in[27]; float* out; unsigned char* ws; int ph_lo, ph_hi;
};
enum { I_X = 0, I_N1G, I_WIN, I_MU, I_W0, I_W2, I_A0, I_A2, I_G2, I_KK, I_KA, I_RK, I_LNW, I_LNB, I_GLNW, I_GLNB, I_GWS, I_GBS, I_WPA, I_WPB, I_WOUT, I_N2G, I_WUP, I_CW, I_CB, I_WDOWN, I_NFG };

__device__ __forceinline__ float bf2f(unsigned short h) { return __uint_as_float(((unsigned)h) << 16); }
__device__ __forceinline__ unsigned f2bf(float f) { unsigned u = __float_as_uint(f); return (u + 0x7fffu + ((u >> 16) & 1u)) >> 16; }
__device__ __forceinline__ unsigned pk2(float lo, float hi) { return f2bf(lo) | (f2bf(hi) << 16); }
__device__ __forceinline__ float wave_sum(float v) {
#pragma unroll
    for (int o = 1; o < 64; o <<= 1) v += __shfl_xor(v, o);
    return v;
}
__device__ __forceinline__ float dpp_shr_z(float v, int ctrl_sel) {
    const int iv = __float_as_int(v); int r;
    switch (ctrl_sel) { case 1: r = __builtin_amdgcn_update_dpp(0, iv, 0x111, 0xf, 0xf, true); break; case 2: r = __builtin_amdgcn_update_dpp(0, iv, 0x112, 0xf, 0xf, true); break;
                        case 4: r = __builtin_amdgcn_update_dpp(0, iv, 0x114, 0xf, 0xf, true); break; default: r = __builtin_amdgcn_update_dpp(0, iv, 0x118, 0xf, 0xf, true); break; }
    return __int_as_float(r);
}
__device__ __forceinline__ void wave_sum2(float& a, float& b) {
    a += dpp_shr_z(a, 1); b += dpp_shr_z(b, 1); a += dpp_shr_z(a, 2); b += dpp_shr_z(b, 2); a += dpp_shr_z(a, 4); b += dpp_shr_z(b, 4); a += dpp_shr_z(a, 8); b += dpp_shr_z(b, 8);
    a += __int_as_float(__builtin_amdgcn_update_dpp(0, __float_as_int(a), 0x142, 0xa, 0xf, false)); b += __int_as_float(__builtin_amdgcn_update_dpp(0, __float_as_int(b), 0x142, 0xa, 0xf, false));
    a += __int_as_float(__builtin_amdgcn_update_dpp(0, __float_as_int(a), 0x143, 0xc, 0xf, false)); b += __int_as_float(__builtin_amdgcn_update_dpp(0, __float_as_int(b), 0x143, 0xc, 0xf, false));
    a = __int_as_float(__builtin_amdgcn_readlane(__float_as_int(a), 63)); b = __int_as_float(__builtin_amdgcn_readlane(__float_as_int(b), 63));
}
__device__ __forceinline__ float gelu_f(float x) { return 0.5f * x * (1.0f + erff(x * 0.70710678118654752f)); }
#define LDS_WAIT() asm volatile("s_waitcnt lgkmcnt(0)" ::: "memory")
#define RLF(v, k) __int_as_float(__builtin_amdgcn_readlane(__float_as_int(v), k))
#define DPPX(v, ctrl) __int_as_float(__builtin_amdgcn_update_dpp(0, __float_as_int(v), ctrl, 0xf, 0xf, false))
__device__ __forceinline__ float sum8(float v) { v += DPPX(v, 0xB1); v += DPPX(v, 0x4E); v += DPPX(v, 0x141); return v; }
__device__ __forceinline__ void ld8(const bf16* p, float (&o)[8]) { const u32x4 w = *(const u32x4*)p;
    o[0] = __uint_as_float(w.x << 16); o[1] = __uint_as_float(w.x & 0xffff0000u); o[2] = __uint_as_float(w.y << 16); o[3] = __uint_as_float(w.y & 0xffff0000u);
    o[4] = __uint_as_float(w.z << 16); o[5] = __uint_as_float(w.z & 0xffff0000u); o[6] = __uint_as_float(w.w << 16); o[7] = __uint_as_float(w.w & 0xffff0000u); }
__device__ __forceinline__ void st8(bf16* p, const float (&v)[8]) { u32x4 w; w.x = pk2(v[0], v[1]); w.y = pk2(v[2], v[3]); w.z = pk2(v[4], v[5]); w.w = pk2(v[6], v[7]); *(u32x4*)p = w; }
__device__ __forceinline__ void st8nt(bf16* p, const float (&v)[8]) { u32x4 w; w.x = pk2(v[0], v[1]); w.y = pk2(v[2], v[3]); w.z = pk2(v[4], v[5]); w.w = pk2(v[6], v[7]); __builtin_nontemporal_store(w, (u32x4*)p); }
__device__ __forceinline__ void ldf8(const float* p, float (&o)[8]) { const f32x4 a = *(const f32x4*)p, b = *(const f32x4*)(p + 4); o[0] = a[0]; o[1] = a[1]; o[2] = a[2]; o[3] = a[3]; o[4] = b[0]; o[5] = b[1]; o[6] = b[2]; o[7] = b[3]; }

__device__ __forceinline__ void tr_item(const float* W, int ldw, int srccol, int k0, const float* kscale, bf16* WT, int K, int drow0, LAS float* scr, int lane) {
    float v[64];
#pragma unroll
    for (int kk = 0; kk < 64; ++kk) v[kk] = (srccol >= 0) ? W[(size_t)(k0 + kk) * ldw + srccol] : 0.f;
    if (kscale) {
#pragma unroll
        for (int kk = 0; kk < 64; kk += 4) { const f32x4 s4 = *(const f32x4*)(kscale + k0 + kk); v[kk] *= s4[0]; v[kk + 1] *= s4[1]; v[kk + 2] *= s4[2]; v[kk + 3] *= s4[3]; } }
#pragma unroll
    for (int kk = 0; kk < 64; ++kk) scr[kk * 65 + lane] = v[kk];
    LDS_WAIT(); asm volatile("" ::: "memory");
    const int c = lane & 7;
#pragma unroll
    for (int j = 0; j < 8; ++j) { const int n = (lane >> 3) + 8 * j; const LAS float* s = scr + (8 * c) * 65 + n;
        u32x4 o; o.x = pk2(s[0 * 65], s[1 * 65]); o.y = pk2(s[2 * 65], s[3 * 65]); o.z = pk2(s[4 * 65], s[5 * 65]); o.w = pk2(s[6 * 65], s[7 * 65]);
        *(u32x4*)(WT + (size_t)(drow0 + n) * K + k0 + 8 * c) = o; }
    LDS_WAIT(); asm volatile("" ::: "memory");
}
template <int PART> __device__ __forceinline__ void convert_weights(const Params& p, LAS unsigned char* lds, int gw, int NGW) {
    const int lane = threadIdx.x & 63, wave = threadIdx.x >> 6;
    LAS float* scr = (LAS float*)(lds + wave * 16640);
    unsigned char* ws = p.ws;
    constexpr int I1 = 32 * 152, I2 = 16 * 32, I3 = 16 * 32, I4 = 32 * 32, I5 = 32 * 176, I6 = 88 * 32;
    if (PART == 0) {
        for (int r = gw; r < I1; r += NGW) { const int kb = r / 152, nb = r % 152, n0 = nb * 64, n = n0 + lane; const int src = n < 5408 ? n : (n < 5632 ? -1 : n - 224);
            tr_item(p.in[I_WIN], 9504, src, kb * 64, p.in[I_N1G], (bf16*)(ws + WS_W_IN), 2048, n0, scr, lane); }
    } else {
        for (int it = gw; it < I2 + I3 + I4 + I5 + I6; it += NGW) {
            int r = it;
            if (r < I2) { const int kb = r / 32, nb = r % 32; tr_item(p.in[I_WPA], 2048, nb * 64 + lane, kb * 64, nullptr, (bf16*)(ws + WS_W_PA), 1024, nb * 64, scr, lane); continue; } r -= I2;
            if (r < I3) { const int kb = r / 32, nb = r % 32; tr_item(p.in[I_WPB], 2048, nb * 64 + lane, kb * 64, nullptr, (bf16*)(ws + WS_W_PB), 1024, nb * 64, scr, lane); continue; } r -= I3;
            if (r < I4) { const int kb = r / 32, nb = r % 32; tr_item(p.in[I_WOUT], 2048, nb * 64 + lane, kb * 64, nullptr, (bf16*)(ws + WS_W_OUT), 2048, nb * 64, scr, lane); continue; } r -= I4;
            if (r < I5) { const int kb = r / 176, nb = r % 176, n0 = nb * 64, n = n0 + lane, j = n >> 8, w = n & 255; const int src = w < 128 ? 128 * j + w : 5632 + 128 * j + (w - 128);
                tr_item(p.in[I_WUP], 11264, src, kb * 64, p.in[I_N2G], (bf16*)(ws + WS_W_UP), 2048, n0, scr, lane); continue; } r -= I5;
            { const int kb = r / 32, nb = r % 32; tr_item(p.in[I_WDOWN], 2048, nb * 64 + lane, kb * 64, nullptr, (bf16*)(ws + WS_W_DOWN), 5632, nb * 64, scr, lane); }
        }
    }
}
__device__ __forceinline__ void phase_prologue(const Params& p, LAS unsigned char* lds) {
    const int tid = threadIdx.x, lane = tid & 63, wave = tid >> 6, G = gridDim.x;
    const int gw = blockIdx.x * NWAVES + wave, NGW = G * NWAVES;
    unsigned char* ws = p.ws;
    convert_weights<0>(p, lds, gw, NGW);
    if (G <= 128) convert_weights<1>(p, lds, gw, NGW);
    { bf16* WL = (bf16*)(ws + WS_W_LORA); const int gt = blockIdx.x * NTHR + tid, NGT = G * NTHR;
      for (int i = gt; i < N_LORA * K_LORA; i += NGT) { const int n = i / K_LORA, k = i % K_LORA; float v = 0.f;
          if (n < 1024) { if (k < 64) v = p.in[I_W2][k * 1024 + n]; }
          else if (n < 2048) { if (k >= 64 && k < 128) v = p.in[I_A2][(k - 64) * 1024 + (n - 1024)]; }
          else { if (k >= 128 && k < 288) v = p.in[I_G2][(k - 128) * 1024 + (n - 2048)]; }
          WL[i] = (bf16)f2bf(v); } }
    { const float* x = p.in[I_X]; bf16* xb = (bf16*)(ws + WS_XB); float* rstd = (float*)(ws + WS_RSTD1);
      constexpr int UR = 4;
      for (int row0 = gw; row0 < T; row0 += UR * NGW) { f32x4 v[UR][8]; float s[UR];
#pragma unroll
          for (int u = 0; u < UR; ++u) { const f32x4* xr = (const f32x4*)(x + (size_t)(row0 + u * NGW) * DM) + lane;
#pragma unroll
              for (int j = 0; j < 8; ++j) v[u][j] = __builtin_nontemporal_load(xr + 64 * j); }
#pragma unroll
          for (int u = 0; u < UR; ++u) { const int row = row0 + u * NGW; s[u] = 0.f;
#pragma unroll
              for (int j = 0; j < 8; ++j) s[u] += (v[u][j][0] * v[u][j][0] + v[u][j][1] * v[u][j][1]) + (v[u][j][2] * v[u][j][2] + v[u][j][3] * v[u][j][3]);
              s[u] = wave_sum(s[u]); if (lane == 0) rstd[row] = 1.0f / sqrtf(s[u] * (1.0f / DM) + 1e-6f);
              u32x2* o = (u32x2*)(xb + (size_t)row * DM) + lane;
#pragma unroll
              for (int j = 0; j < 8; ++j) { u32x2 w; w.x = pk2(v[u][j][0], v[u][j][1]); w.y = pk2(v[u][j][2], v[u][j][3]); o[64 * j] = w; } } } }
}

__device__ __forceinline__ void phase_gmlp(const Params& p, LAS unsigned char* lds) {
    const int tid = threadIdx.x, lane = tid & 63, wave = tid >> 6, G = gridDim.x;
    unsigned char* ws = p.ws;
    const bf16* AU = (const bf16*)(ws + WS_AU); const bf16* AV = (const bf16*)(ws + WS_AV); bf16* YA = (bf16*)(ws + WS_YA);
    const float* LNS = (const float*)(ws + WS_SSQ2);
    LAS bf16* WM = (LAS bf16*)lds;
    LAS bf16* VT = (LAS bf16*)(lds + 34816);
    LAS float* st = (LAS float*)(lds + 69632);
    const int g = blockIdx.x & 7, nb = G >> 3;
    if ((int)blockIdx.x < nb * 8) {
        __syncthreads();
        { const float* wg = p.in[I_GWS] + (size_t)g * 16384;
#pragma unroll
          for (int j = 0; j < 8; ++j) { const int e = tid + 512 * j, t = e >> 5, s4 = (e & 31) * 4; f32x4 w = *(const f32x4*)(wg + t * 128 + s4);
#pragma unroll
              for (int i = 0; i < 4; ++i) if (s4 + i > t) w[i] = 0.f;
              u32x2 o; o.x = pk2(w[0], w[1]); o.y = pk2(w[2], w[3]); *(LAS u32x2*)(WM + t * 136 + s4) = o; } }
        const int c8 = (tid & 15) * 8;
        float lw8[8], lb8[8]; ldf8(p.in[I_GLNW] + g * 128 + c8, lw8); ldf8(p.in[I_GLNB] + g * 128 + c8, lb8);
        const float* bsg = p.in[I_GBS] + g * 128;
        u32x4 avn[4];
        { const int ch0 = blockIdx.x >> 3;
#pragma unroll
          for (int i = 0; i < 4; ++i) { const int s = (tid >> 4) + 32 * i; avn[i] = (ch0 < T / 128) ? *(const u32x4*)(AV + (size_t)(ch0 * 128 + s) * DA + g * 128 + c8) : (u32x4){0u, 0u, 0u, 0u}; } }
        for (int ch = blockIdx.x >> 3; ch < T / 128; ch += nb) {
            const int t0 = ch * 128;
            float av[4][8];
#pragma unroll
            for (int i = 0; i < 4; ++i) { f32x4 x0, x1; pg8::unpack8(avn[i], x0, x1); av[i][0] = x0[0]; av[i][1] = x0[1]; av[i][2] = x0[2]; av[i][3] = x0[3]; av[i][4] = x1[0]; av[i][5] = x1[1]; av[i][6] = x1[2]; av[i][7] = x1[3]; }
            if (tid < 128) { const f32x4* q = (const f32x4*)(LNS + (size_t)(t0 + tid) * 32); f32x4 a = q[0] + q[1] + q[2] + q[3], b = q[4] + q[5] + q[6] + q[7];
                const float mean = ((a[0] + a[1]) + (a[2] + a[3])) * (1.0f / DA), ex2 = ((b[0] + b[1]) + (b[2] + b[3])) * (1.0f / DA);
                st[tid] = mean; st[128 + tid] = 1.0f / sqrtf(fmaxf(ex2 - mean * mean, 0.f) + 1e-5f); }
            __syncthreads();
#pragma unroll
            for (int i = 0; i < 4; ++i) { const int s = (tid >> 4) + 32 * i; const float mean = st[s], rs = st[128 + s];
#pragma unroll
                for (int j = 0; j < 8; ++j) VT[(c8 + j) * 136 + ((((s >> 3) ^ (tid & 15)) << 3) | (s & 7))] = (bf16)f2bf((av[i][j] - mean) * rs * lw8[j] + lb8[j]); }
            __syncthreads();
            if (ch + nb < T / 128) {
#pragma unroll
                for (int i = 0; i < 4; ++i) { const int s = (tid >> 4) + 32 * i; avn[i] = *(const u32x4*)(AV + (size_t)((ch + nb) * 128 + s) * DA + g * 128 + c8); } }
            const size_t rowo = (size_t)(t0 + 16 * wave + (lane & 15)) * DA + g * 128 + 4 * (lane >> 4);
            u32x2 aur[8];
#pragma unroll
            for (int ct = 0; ct < 8; ++ct) aur[ct] = *(const u32x2*)(AU + rowo + 16 * ct);
            f32x4 acc[8];
#pragma unroll
            for (int ct = 0; ct < 8; ++ct) acc[ct] = (f32x4){0.f, 0.f, 0.f, 0.f};
            const int nk = (16 * wave + 15) / 32 + 1;
            for (int ks = 0; ks < nk; ++ks) { const bf16x8 wmf = *(const LAS bf16x8*)(WM + (16 * wave + (lane & 15)) * 136 + ks * 32 + 8 * (lane >> 4));
#pragma unroll
                for (int ct = 0; ct < 8; ++ct) { const bf16x8 vtf = *(const LAS bf16x8*)(VT + (16 * ct + (lane & 15)) * 136 + (((ks * 4 + (lane >> 4)) ^ (2 * ct + ((lane & 15) >> 3))) << 3));
                    acc[ct] = __builtin_amdgcn_mfma_f32_16x16x32_bf16(vtf, wmf, acc[ct], 0, 0, 0); } }
            { const float bsv = bsg[16 * wave + (lane & 15)];
#pragma unroll
              for (int ct = 0; ct < 8; ++ct) { const u32x2 aw = aur[ct];
                  const float o0 = (acc[ct][0] + bsv) * __uint_as_float(aw.x << 16), o1 = (acc[ct][1] + bsv) * __uint_as_float(aw.x & 0xffff0000u);
                  const float o2 = (acc[ct][2] + bsv) * __uint_as_float(aw.y << 16), o3 = (acc[ct][3] + bsv) * __uint_as_float(aw.y & 0xffff0000u);
                  u32x2 w; w.x = pk2(o0, o1); w.y = pk2(o2, o3); *(u32x2*)(YA + rowo + 16 * ct) = w; } }
        }
    }
    { const bf16* LRAW = (const bf16*)(ws + WS_LRAW); bf16* LIN = (bf16*)(ws + WS_LIN); const float* mu = p.in[I_MU];
      const int gt = blockIdx.x * NTHR + tid, NGT = G * NTHR;
      for (int i0 = gt; i0 < T * 48; i0 += 4 * NGT) { float cur[4][8], prev[4][8];
#pragma unroll
          for (int u = 0; u < 4; ++u) { const int i = i0 + u * NGT; if (i < T * 48) { const int t = i / 48, c = (i % 48) * 8;
              if (c < 288) { ld8(LRAW + (size_t)t * 512 + c, cur[u]); ld8(LRAW + (size_t)((t % SEQ) ? t - 1 : t) * 512 + c, prev[u]); } } }
#pragma unroll
          for (int u = 0; u < 4; ++u) { const int i = i0 + u * NGT; if (i < T * 48) { const int t = i / 48, c = (i % 48) * 8; float o[8];
              if (c < 288) { float m8[8]; ldf8(mu + 3072 + c, m8); const bool first = (t % SEQ) == 0;
#pragma unroll
                  for (int j = 0; j < 8; ++j) { const float pv = first ? 0.f : prev[u][j]; const float m = cur[u][j] + (pv - cur[u][j]) * m8[j];
                      o[j] = c < 64 ? tanhf(m) : (c < 128 ? m : 1.0f / (1.0f + __expf(-m))); } }
              else {
#pragma unroll
                  for (int j = 0; j < 8; ++j) o[j] = 0.f; }
              st8(LIN + (size_t)t * K_LORA + c, o); } } } }
}

#define SCAN_FENCE(j)
template <bool PASS2> struct ScanCfg { static constexpr int SB = 4; };
template <bool PASS2, int MODE = 0> __device__ __forceinline__ void phase_scan(const Params& p, LAS unsigned char* lds) {
    constexpr int SB = ScanCfg<PASS2>::SB; constexpr int NV = PASS2 ? 8 : 6;
    const int tid = threadIdx.x, lane = tid & 63, wave = tid >> 6, G = gridDim.x;
    const int gw = blockIdx.x * NWAVES + wave, NGW = G * NWAVES;
    unsigned char* ws = p.ws;
    const float* DEC = (const float*)(ws + WS_DEC);
    const bf16* R = (const bf16*)p.out; const bf16* KF = R + (size_t)T * DB; const bf16* V = KF + (size_t)T * DB; const bf16* KKN = V + (size_t)T * DB; const bf16* Bv = (const bf16*)(ws + WS_B);
    const bf16* Gt = (const bf16*)(ws + WS_G); const float* BON = (const float*)(ws + WS_BONUS); bf16* YB = (bf16*)(ws + WS_YB);
    float* ST = (float*)(ws + WS_ST); float* YT = (float*)p.out; bf16* ZT = (bf16*)p.out + (size_t)3 * T * DB;
    const bf16* FEAT = (const bf16*)(ws + WS_FEAT); const bf16* AS = (const bf16*)(ws + WS_AS); bf16* Vw = (bf16*)p.out + (size_t)2 * T * DB; float* BONw = (float*)(ws + WS_BONUS);
    LAS float* buf = (LAS float*)(lds + wave * 16384);
    for (int u = gw; u < 32 * NCH; u += NGW) {
        const int bh = u / NCH, ch = u % NCH, b = bh >> 4, h = bh & 15; int lnl = lane; asm volatile("" : "+v"(lnl));
        const unsigned i0 = (unsigned)((b * SEQ + ch * CL) * DB + h * 64) + (unsigned)lnl;
        const unsigned q0 = (unsigned)((b * SEQ + ch * CL) * NH + h);
        const unsigned f0 = (unsigned)((b * SEQ + ch * CL) * 3072 + h * 64) + (unsigned)lnl;
        const int cc_ = h * 64 + lnl;
        const float mur = p.in[I_MU][cc_], muk = p.in[I_MU][1024 + cc_], muv = p.in[I_MU][2048 + cc_], ckk = p.in[I_KK][cc_], cka = p.in[I_KA][cc_], crk = p.in[I_RK][cc_];
        float pr = 0.f, pk = 0.f, pv = 0.f;
        if (ch > 0) { pr = bf2f(FEAT[f0 - 3072u]); pk = bf2f(FEAT[f0 - 3072u + 1024]); pv = bf2f(FEAT[f0 - 3072u + 2048]); }
        f32x2 Q2[32], P2[32];
#pragma unroll
        for (int k = 0; k < 32; ++k) { Q2[k] = (f32x2){0.f, 0.f}; P2[k] = (f32x2){(2 * k == lnl) ? 1.f : 0.f, (2 * k + 1 == lnl) ? 1.f : 0.f}; }
        float lw = 0.f, lb = 0.f;
        if (PASS2) { lw = p.in[I_LNW][h * 64 + lane]; lb = p.in[I_LNB][h * 64 + lane];
            if (ch > 0) { const f32x4* s = (const f32x4*)(ST + ((size_t)(u - 1) * 2) * 4096 + lane * 64);
#pragma unroll
                for (int j = 0; j < 16; ++j) { const f32x4 x = s[j]; Q2[2 * j] = x.xy; Q2[2 * j + 1] = x.zw; } } }
        float rg[SB][NV];
#define SCAN_LOAD(seg) do { _Pragma("unroll") for (int s = 0; s < SB; ++s) { const unsigned st_ = (unsigned)((seg) * SB + s); const unsigned ix = i0 + st_ * DB, fx = f0 + st_ * 3072u; \
            rg[s][0] = DEC[ix]; rg[s][1] = bf2f(FEAT[fx]); rg[s][2] = bf2f(FEAT[fx + 1024]); rg[s][3] = bf2f(FEAT[fx + 2048]); rg[s][4] = bf2f(AS[ix]); } } while (0)
#define SCAN_STORE(bi, seg) do { _Pragma("unroll") for (int s = 0; s < SB; ++s) { const unsigned st_ = (unsigned)((seg) * SB + s); \
            const float cr_ = rg[s][1], ck_ = rg[s][2], cv_ = rg[s][3], a_ = rg[s][4]; \
            const float r_ = cr_ + (pr - cr_) * mur, k_ = ck_ + (pk - ck_) * muk, v_ = cv_ + (pv - cv_) * muv; pr = cr_; pk = ck_; pv = cv_; \
            const float kk_ = k_ * ckk, kf_ = k_ * (1.0f + (a_ - 1.0f) * cka); float n2_ = kk_ * kk_, bon_ = r_ * kf_ * crk; wave_sum2(n2_, bon_); \
            const float kkn_ = kk_ * __builtin_amdgcn_rsqf(fmaxf(n2_, 1e-24f)); \
            LAS float* d_ = buf + (((bi) * SB + s) * NV) * 64 + lane; d_[0] = rg[s][0]; d_[64] = kkn_; d_[128] = kkn_ * a_; d_[192] = kf_; d_[256] = v_; d_[320] = r_; \
            if (MODE == 0) { Vw[i0 + st_ * DB] = (bf16)f2bf(v_); if (lane == 0) BONw[q0 + st_ * NH] = bon_; } } } while (0)
        SCAN_LOAD(0); SCAN_STORE(0, 0);
        for (int seg = 0; seg < CL / SB; ++seg) {
            const int bi = seg & 1;
            if (MODE != 2 && seg + 1 < CL / SB) SCAN_LOAD(seg + 1);
            asm volatile("" ::: "memory");
#define RLF_UNUSED 0
#define DPPFMAC(acc, rep, val, n) asm("v_fmac_f32_dpp %0, %1, %2 row_newbcast:" #n " row_mask:0xf bank_mask:0xf" : "+v"(acc) : "v"(rep), "v"(val))
#pragma unroll 1
            for (int s = 0; s < (MODE == 1 ? 0 : SB); ++s) {
                const LAS float* sv = buf + ((bi * SB + s) * NV) * 64;
                const LAS f32x4* L4 = (const LAS f32x4*)sv;
                f32x2 qloa = {0.f, 0.f}, qhia = qloa, qlob = qloa, qhib = qloa, plo = qloa, phi = qloa, yloa = qloa, yhia = qloa, ylob = qloa, yhib = qloa, saq2 = qloa, sap2 = qloa;
                const float vv = sv[4 * 64 + lane]; const f32x2 vv2 = {vv, vv};
                const float xk = sv[1 * 64 + lane], xb = sv[2 * 64 + lane], xr = sv[5 * 64 + lane];
                float qd0 = 0.f, qd1 = 0.f, qd2 = 0.f, qd3 = 0.f, pd0 = 0.f, pd1 = 0.f, pd2 = 0.f, pd3 = 0.f, yd0 = 0.f, yd1 = 0.f, yd2 = 0.f, yd3 = 0.f, zd0 = 0.f, zd1 = 0.f, zd2 = 0.f, zd3 = 0.f;
                const int l15 = lane & 15; float xkq0 = sv[64 + l15], xkq1 = sv[64 + 16 + l15], xkq2 = sv[64 + 32 + l15], xkq3 = sv[64 + 48 + l15], xrq0 = sv[320 + l15], xrq1 = sv[320 + 16 + l15], xrq2 = sv[320 + 32 + l15], xrq3 = sv[320 + 48 + l15];
                asm volatile("s_nop 1" : "+v"(xkq0), "+v"(xkq1), "+v"(xkq2), "+v"(xkq3));
                if constexpr (PASS2) {
                __builtin_amdgcn_sched_barrier(0);
                { const f32x2 kxy = (f32x2){RLF(xk, 0), RLF(xk, 1)}, kzw = (f32x2){RLF(xk, 2), RLF(xk, 3)};
                qloa += Q2[0] * kxy; qhia += Q2[1] * kzw; }
                { const f32x2 kxy = (f32x2){RLF(xk, 4), RLF(xk, 5)}, kzw = (f32x2){RLF(xk, 6), RLF(xk, 7)};
                qlob += Q2[2] * kxy; qhib += Q2[3] * kzw; }
                { const f32x2 kxy = (f32x2){RLF(xk, 8), RLF(xk, 9)}, kzw = (f32x2){RLF(xk, 10), RLF(xk, 11)};
                qloa += Q2[4] * kxy; qhia += Q2[5] * kzw; }
                { const f32x2 kxy = (f32x2){RLF(xk, 12), RLF(xk, 13)}, kzw = (f32x2){RLF(xk, 14), RLF(xk, 15)};
                qlob += Q2[6] * kxy; qhib += Q2[7] * kzw; }
                __builtin_amdgcn_sched_barrier(0);
                { const f32x2 kxy = (f32x2){RLF(xk, 16), RLF(xk, 17)}, kzw = (f32x2){RLF(xk, 18), RLF(xk, 19)};
                qloa += Q2[8] * kxy; qhia += Q2[9] * kzw; }
                { const f32x2 kxy = (f32x2){RLF(xk, 20), RLF(xk, 21)}, kzw = (f32x2){RLF(xk, 22), RLF(xk, 23)};
                qlob += Q2[10] * kxy; qhib += Q2[11] * kzw; }
                { const f32x2 kxy = (f32x2){RLF(xk, 24), RLF(xk, 25)}, kzw = (f32x2){RLF(xk, 26), RLF(xk, 27)};
                qloa += Q2[12] * kxy; qhia += Q2[13] * kzw; }
                { const f32x2 kxy = (f32x2){RLF(xk, 28), RLF(xk, 29)}, kzw = (f32x2){RLF(xk, 30), RLF(xk, 31)};
                qlob += Q2[14] * kxy; qhib += Q2[15] * kzw; }
                __builtin_amdgcn_sched_barrier(0);
                f32x4 d_0 = L4[0], k_0 = L4[48];
                f32x4 r_0 = L4[80];
                f32x4 d_1 = L4[1], k_1 = L4[49];
                f32x4 r_1 = L4[81];
                { const f32x2 kxy = (f32x2){RLF(xk, 32), RLF(xk, 33)}, kzw = (f32x2){RLF(xk, 34), RLF(xk, 35)};
                qloa += Q2[16] * kxy; qhia += Q2[17] * kzw; }
                { const f32x2 kxy = (f32x2){RLF(xk, 36), RLF(xk, 37)}, kzw = (f32x2){RLF(xk, 38), RLF(xk, 39)};
                qlob += Q2[18] * kxy; qhib += Q2[19] * kzw; }
                { const f32x2 kxy = (f32x2){RLF(xk, 40), RLF(xk, 41)}, kzw = (f32x2){RLF(xk, 42), RLF(xk, 43)};
                qloa += Q2[20] * kxy; qhia += Q2[21] * kzw; }
                { const f32x2 kxy = (f32x2){RLF(xk, 44), RLF(xk, 45)}, kzw = (f32x2){RLF(xk, 46), RLF(xk, 47)};
                qlob += Q2[22] * kxy; qhib += Q2[23] * kzw; }
                __builtin_amdgcn_sched_barrier(0);
                f32x4 d_2 = L4[2], k_2 = L4[50];
                f32x4 r_2 = L4[82];
                f32x4 d_3 = L4[3], k_3 = L4[51];
                f32x4 r_3 = L4[83];
                { const f32x2 kxy = (f32x2){RLF(xk, 48), RLF(xk, 49)}, kzw = (f32x2){RLF(xk, 50), RLF(xk, 51)};
                qloa += Q2[24] * kxy; qhia += Q2[25] * kzw; }
                { const f32x2 kxy = (f32x2){RLF(xk, 52), RLF(xk, 53)}, kzw = (f32x2){RLF(xk, 54), RLF(xk, 55)};
                qlob += Q2[26] * kxy; qhib += Q2[27] * kzw; }
                { const f32x2 kxy = (f32x2){RLF(xk, 56), RLF(xk, 57)}, kzw = (f32x2){RLF(xk, 58), RLF(xk, 59)};
                qloa += Q2[28] * kxy; qhia += Q2[29] * kzw; }
                { const f32x2 kxy = (f32x2){RLF(xk, 60), RLF(xk, 61)}, kzw = (f32x2){RLF(xk, 62), RLF(xk, 63)};
                qlob += Q2[30] * kxy; qhib += Q2[31] * kzw; }
                { const f32x2 qs = (qloa + qlob) + (qhia + qhib), ps = plo + phi; const float saq = -(qs.x + qs.y), sap = -(ps.x + ps.y); saq2 = (f32x2){saq, saq}; sap2 = (f32x2){sap, sap}; }
                __builtin_amdgcn_sched_barrier(0);
                f32x4 d_4 = L4[4], k_4 = L4[52];
                f32x4 r_4 = L4[84];
                f32x4 d_5 = L4[5], k_5 = L4[53];
                f32x4 r_5 = L4[85];
                { const f32x2 bxy = (f32x2){RLF(xb, 0), RLF(xb, 1)}, bzw = (f32x2){RLF(xb, 2), RLF(xb, 3)};
                Q2[0] = Q2[0] * d_0.xy + (saq2 * bxy + vv2 * k_0.xy); Q2[1] = Q2[1] * d_0.zw + (saq2 * bzw + vv2 * k_0.zw);
                yloa += Q2[0] * r_0.xy; yhia += Q2[1] * r_0.zw; }
                { const f32x2 bxy = (f32x2){RLF(xb, 4), RLF(xb, 5)}, bzw = (f32x2){RLF(xb, 6), RLF(xb, 7)};
                Q2[2] = Q2[2] * d_1.xy + (saq2 * bxy + vv2 * k_1.xy); Q2[3] = Q2[3] * d_1.zw + (saq2 * bzw + vv2 * k_1.zw);
                ylob += Q2[2] * r_1.xy; yhib += Q2[3] * r_1.zw; }
                __builtin_amdgcn_sched_barrier(0);
                f32x4 d_6 = L4[6], k_6 = L4[54];
                f32x4 r_6 = L4[86];
                f32x4 d_7 = L4[7], k_7 = L4[55];
                f32x4 r_7 = L4[87];
                { const f32x2 bxy = (f32x2){RLF(xb, 8), RLF(xb, 9)}, bzw = (f32x2){RLF(xb, 10), RLF(xb, 11)};
                Q2[4] = Q2[4] * d_2.xy + (saq2 * bxy + vv2 * k_2.xy); Q2[5] = Q2[5] * d_2.zw + (saq2 * bzw + vv2 * k_2.zw);
                yloa += Q2[4] * r_2.xy; yhia += Q2[5] * r_2.zw; }
                { const f32x2 bxy = (f32x2){RLF(xb, 12), RLF(xb, 13)}, bzw = (f32x2){RLF(xb, 14), RLF(xb, 15)};
                Q2[6] = Q2[6] * d_3.xy + (saq2 * bxy + vv2 * k_3.xy); Q2[7] = Q2[7] * d_3.zw + (saq2 * bzw + vv2 * k_3.zw);
                ylob += Q2[6] * r_3.xy; yhib += Q2[7] * r_3.zw; }
                __builtin_amdgcn_sched_barrier(0);
                f32x4 d_8 = L4[8], k_8 = L4[56];
                f32x4 r_8 = L4[88];
                f32x4 d_9 = L4[9], k_9 = L4[57];
                f32x4 r_9 = L4[89];
                { const f32x2 bxy = (f32x2){RLF(xb, 16), RLF(xb, 17)}, bzw = (f32x2){RLF(xb, 18), RLF(xb, 19)};
                Q2[8] = Q2[8] * d_4.xy + (saq2 * bxy + vv2 * k_4.xy); Q2[9] = Q2[9] * d_4.zw + (saq2 * bzw + vv2 * k_4.zw);
                yloa += Q2[8] * r_4.xy; yhia += Q2[9] * r_4.zw; }
                { const f32x2 bxy = (f32x2){RLF(xb, 20), RLF(xb, 21)}, bzw = (f32x2){RLF(xb, 22), RLF(xb, 23)};
                Q2[10] = Q2[10] * d_5.xy + (saq2 * bxy + vv2 * k_5.xy); Q2[11] = Q2[11] * d_5.zw + (saq2 * bzw + vv2 * k_5.zw);
                ylob += Q2[10] * r_5.xy; yhib += Q2[11] * r_5.zw; }
                __builtin_amdgcn_sched_barrier(0);
                f32x4 d_10 = L4[10], k_10 = L4[58];
                f32x4 r_10 = L4[90];
                f32x4 d_11 = L4[11], k_11 = L4[59];
                f32x4 r_11 = L4[91];
                { const f32x2 bxy = (f32x2){RLF(xb, 24), RLF(xb, 25)}, bzw = (f32x2){RLF(xb, 26), RLF(xb, 27)};
                Q2[12] = Q2[12] * d_6.xy + (saq2 * bxy + vv2 * k_6.xy); Q2[13] = Q2[13] * d_6.zw + (saq2 * bzw + vv2 * k_6.zw);
                yloa += Q2[12] * r_6.xy; yhia += Q2[13] * r_6.zw; }
                { const f32x2 bxy = (f32x2){RLF(xb, 28), RLF(xb, 29)}, bzw = (f32x2){RLF(xb, 30), RLF(xb, 31)};
                Q2[14] = Q2[14] * d_7.xy + (saq2 * bxy + vv2 * k_7.xy); Q2[15] = Q2[15] * d_7.zw + (saq2 * bzw + vv2 * k_7.zw);
                ylob += Q2[14] * r_7.xy; yhib += Q2[15] * r_7.zw; }
                __builtin_amdgcn_sched_barrier(0);
                f32x4 d_12 = L4[12], k_12 = L4[60];
                f32x4 r_12 = L4[92];
                f32x4 d_13 = L4[13], k_13 = L4[61];
                f32x4 r_13 = L4[93];
                { const f32x2 bxy = (f32x2){RLF(xb, 32), RLF(xb, 33)}, bzw = (f32x2){RLF(xb, 34), RLF(xb, 35)};
                Q2[16] = Q2[16] * d_8.xy + (saq2 * bxy + vv2 * k_8.xy); Q2[17] = Q2[17] * d_8.zw + (saq2 * bzw + vv2 * k_8.zw);
                yloa += Q2[16] * r_8.xy; yhia += Q2[17] * r_8.zw; }
                { const f32x2 bxy = (f32x2){RLF(xb, 36), RLF(xb, 37)}, bzw = (f32x2){RLF(xb, 38), RLF(xb, 39)};
                Q2[18] = Q2[18] * d_9.xy + (saq2 * bxy + vv2 * k_9.xy); Q2[19] = Q2[19] * d_9.zw + (saq2 * bzw + vv2 * k_9.zw);
                ylob += Q2[18] * r_9.xy; yhib += Q2[19] * r_9.zw; }
                __builtin_amdgcn_sched_barrier(0);
                f32x4 d_14 = L4[14], k_14 = L4[62];
                f32x4 r_14 = L4[94];
                f32x4 d_15 = L4[15], k_15 = L4[63];
                f32x4 r_15 = L4[95];
                { const f32x2 bxy = (f32x2){RLF(xb, 40), RLF(xb, 41)}, bzw = (f32x2){RLF(xb, 42), RLF(xb, 43)};
                Q2[20] = Q2[20] * d_10.xy + (saq2 * bxy + vv2 * k_10.xy); Q2[21] = Q2[21] * d_10.zw + (saq2 * bzw + vv2 * k_10.zw);
                yloa += Q2[20] * r_10.xy; yhia += Q2[21] * r_10.zw; }
                { const f32x2 bxy = (f32x2){RLF(xb, 44), RLF(xb, 45)}, bzw = (f32x2){RLF(xb, 46), RLF(xb, 47)};
                Q2[22] = Q2[22] * d_11.xy + (saq2 * bxy + vv2 * k_11.xy); Q2[23] = Q2[23] * d_11.zw + (saq2 * bzw + vv2 * k_11.zw);
                ylob += Q2[22] * r_11.xy; yhib += Q2[23] * r_11.zw; }
                __builtin_amdgcn_sched_barrier(0);
                { const f32x2 bxy = (f32x2){RLF(xb, 48), RLF(xb, 49)}, bzw = (f32x2){RLF(xb, 50), RLF(xb, 51)};
                Q2[24] = Q2[24] * d_12.xy + (saq2 * bxy + vv2 * k_12.xy); Q2[25] = Q2[25] * d_12.zw + (saq2 * bzw + vv2 * k_12.zw);
                yloa += Q2[24] * r_12.xy; yhia += Q2[25] * r_12.zw; }
                { const f32x2 bxy = (f32x2){RLF(xb, 52), RLF(xb, 53)}, bzw = (f32x2){RLF(xb, 54), RLF(xb, 55)};
                Q2[26] = Q2[26] * d_13.xy + (saq2 * bxy + vv2 * k_13.xy); Q2[27] = Q2[27] * d_13.zw + (saq2 * bzw + vv2 * k_13.zw);
                ylob += Q2[26] * r_13.xy; yhib += Q2[27] * r_13.zw; }
                __builtin_amdgcn_sched_barrier(0);
                { const f32x2 bxy = (f32x2){RLF(xb, 56), RLF(xb, 57)}, bzw = (f32x2){RLF(xb, 58), RLF(xb, 59)};
                Q2[28] = Q2[28] * d_14.xy + (saq2 * bxy + vv2 * k_14.xy); Q2[29] = Q2[29] * d_14.zw + (saq2 * bzw + vv2 * k_14.zw);
                yloa += Q2[28] * r_14.xy; yhia += Q2[29] * r_14.zw; }
                { const f32x2 bxy = (f32x2){RLF(xb, 60), RLF(xb, 61)}, bzw = (f32x2){RLF(xb, 62), RLF(xb, 63)};
                Q2[30] = Q2[30] * d_15.xy + (saq2 * bxy + vv2 * k_15.xy); Q2[31] = Q2[31] * d_15.zw + (saq2 * bzw + vv2 * k_15.zw);
                ylob += Q2[30] * r_15.xy; yhib += Q2[31] * r_15.zw; }
                __builtin_amdgcn_sched_barrier(0);
                } else {
                __builtin_amdgcn_sched_barrier(0);
                DPPFMAC(qd0, xkq0, Q2[0].x, 0); DPPFMAC(pd0, xkq0, P2[0].x, 0);
                DPPFMAC(qd1, xkq0, Q2[0].y, 1); DPPFMAC(pd1, xkq0, P2[0].y, 1);
                DPPFMAC(qd2, xkq0, Q2[1].x, 2); DPPFMAC(pd2, xkq0, P2[1].x, 2);
                DPPFMAC(qd3, xkq0, Q2[1].y, 3); DPPFMAC(pd3, xkq0, P2[1].y, 3);
                DPPFMAC(qd0, xkq0, Q2[2].x, 4); DPPFMAC(pd0, xkq0, P2[2].x, 4);
                DPPFMAC(qd1, xkq0, Q2[2].y, 5); DPPFMAC(pd1, xkq0, P2[2].y, 5);
                DPPFMAC(qd2, xkq0, Q2[3].x, 6); DPPFMAC(pd2, xkq0, P2[3].x, 6);
                DPPFMAC(qd3, xkq0, Q2[3].y, 7); DPPFMAC(pd3, xkq0, P2[3].y, 7);
                DPPFMAC(qd0, xkq0, Q2[4].x, 8); DPPFMAC(pd0, xkq0, P2[4].x, 8);
                DPPFMAC(qd1, xkq0, Q2[4].y, 9); DPPFMAC(pd1, xkq0, P2[4].y, 9);
                DPPFMAC(qd2, xkq0, Q2[5].x, 10); DPPFMAC(pd2, xkq0, P2[5].x, 10);
                DPPFMAC(qd3, xkq0, Q2[5].y, 11); DPPFMAC(pd3, xkq0, P2[5].y, 11);
                DPPFMAC(qd0, xkq0, Q2[6].x, 12); DPPFMAC(pd0, xkq0, P2[6].x, 12);
                DPPFMAC(qd1, xkq0, Q2[6].y, 13); DPPFMAC(pd1, xkq0, P2[6].y, 13);
                DPPFMAC(qd2, xkq0, Q2[7].x, 14); DPPFMAC(pd2, xkq0, P2[7].x, 14);
                DPPFMAC(qd3, xkq0, Q2[7].y, 15); DPPFMAC(pd3, xkq0, P2[7].y, 15);
                __builtin_amdgcn_sched_barrier(0);
                DPPFMAC(qd0, xkq1, Q2[8].x, 0); DPPFMAC(pd0, xkq1, P2[8].x, 0);
                DPPFMAC(qd1, xkq1, Q2[8].y, 1); DPPFMAC(pd1, xkq1, P2[8].y, 1);
                DPPFMAC(qd2, xkq1, Q2[9].x, 2); DPPFMAC(pd2, xkq1, P2[9].x, 2);
                DPPFMAC(qd3, xkq1, Q2[9].y, 3); DPPFMAC(pd3, xkq1, P2[9].y, 3);
                DPPFMAC(qd0, xkq1, Q2[10].x, 4); DPPFMAC(pd0, xkq1, P2[10].x, 4);
                DPPFMAC(qd1, xkq1, Q2[10].y, 5); DPPFMAC(pd1, xkq1, P2[10].y, 5);
                DPPFMAC(qd2, xkq1, Q2[11].x, 6); DPPFMAC(pd2, xkq1, P2[11].x, 6);
                DPPFMAC(qd3, xkq1, Q2[11].y, 7); DPPFMAC(pd3, xkq1, P2[11].y, 7);
                DPPFMAC(qd0, xkq1, Q2[12].x, 8); DPPFMAC(pd0, xkq1, P2[12].x, 8);
                DPPFMAC(qd1, xkq1, Q2[12].y, 9); DPPFMAC(pd1, xkq1, P2[12].y, 9);
                DPPFMAC(qd2, xkq1, Q2[13].x, 10); DPPFMAC(pd2, xkq1, P2[13].x, 10);
                DPPFMAC(qd3, xkq1, Q2[13].y, 11); DPPFMAC(pd3, xkq1, P2[13].y, 11);
                DPPFMAC(qd0, xkq1, Q2[14].x, 12); DPPFMAC(pd0, xkq1, P2[14].x, 12);
                DPPFMAC(qd1, xkq1, Q2[14].y, 13); DPPFMAC(pd1, xkq1, P2[14].y, 13);
                DPPFMAC(qd2, xkq1, Q2[15].x, 14); DPPFMAC(pd2, xkq1, P2[15].x, 14);
                DPPFMAC(qd3, xkq1, Q2[15].y, 15); DPPFMAC(pd3, xkq1, P2[15].y, 15);
                __builtin_amdgcn_sched_barrier(0);
                DPPFMAC(qd0, xkq2, Q2[16].x, 0); DPPFMAC(pd0, xkq2, P2[16].x, 0);
                DPPFMAC(qd1, xkq2, Q2[16].y, 1); DPPFMAC(pd1, xkq2, P2[16].y, 1);
                DPPFMAC(qd2, xkq2, Q2[17].x, 2); DPPFMAC(pd2, xkq2, P2[17].x, 2);
                DPPFMAC(qd3, xkq2, Q2[17].y, 3); DPPFMAC(pd3, xkq2, P2[17].y, 3);
                DPPFMAC(qd0, xkq2, Q2[18].x, 4); DPPFMAC(pd0, xkq2, P2[18].x, 4);
                DPPFMAC(qd1, xkq2, Q2[18].y, 5); DPPFMAC(pd1, xkq2, P2[18].y, 5);
                DPPFMAC(qd2, xkq2, Q2[19].x, 6); DPPFMAC(pd2, xkq2, P2[19].x, 6);
                DPPFMAC(qd3, xkq2, Q2[19].y, 7); DPPFMAC(pd3, xkq2, P2[19].y, 7);
                DPPFMAC(qd0, xkq2, Q2[20].x, 8); DPPFMAC(pd0, xkq2, P2[20].x, 8);
                DPPFMAC(qd1, xkq2, Q2[20].y, 9); DPPFMAC(pd1, xkq2, P2[20].y, 9);
                DPPFMAC(qd2, xkq2, Q2[21].x, 10); DPPFMAC(pd2, xkq2, P2[21].x, 10);
                DPPFMAC(qd3, xkq2, Q2[21].y, 11); DPPFMAC(pd3, xkq2, P2[21].y, 11);
                DPPFMAC(qd0, xkq2, Q2[22].x, 12); DPPFMAC(pd0, xkq2, P2[22].x, 12);
                DPPFMAC(qd1, xkq2, Q2[22].y, 13); DPPFMAC(pd1, xkq2, P2[22].y, 13);
                DPPFMAC(qd2, xkq2, Q2[23].x, 14); DPPFMAC(pd2, xkq2, P2[23].x, 14);
                DPPFMAC(qd3, xkq2, Q2[23].y, 15); DPPFMAC(pd3, xkq2, P2[23].y, 15);
                __builtin_amdgcn_sched_barrier(0);
                f32x4 d_0 = L4[0], b_0 = L4[32], k_0 = L4[48];
                f32x4 d_1 = L4[1], b_1 = L4[33], k_1 = L4[49];
                DPPFMAC(qd0, xkq3, Q2[24].x, 0); DPPFMAC(pd0, xkq3, P2[24].x, 0);
                DPPFMAC(qd1, xkq3, Q2[24].y, 1); DPPFMAC(pd1, xkq3, P2[24].y, 1);
                DPPFMAC(qd2, xkq3, Q2[25].x, 2); DPPFMAC(pd2, xkq3, P2[25].x, 2);
                DPPFMAC(qd3, xkq3, Q2[25].y, 3); DPPFMAC(pd3, xkq3, P2[25].y, 3);
                DPPFMAC(qd0, xkq3, Q2[26].x, 4); DPPFMAC(pd0, xkq3, P2[26].x, 4);
                DPPFMAC(qd1, xkq3, Q2[26].y, 5); DPPFMAC(pd1, xkq3, P2[26].y, 5);
                DPPFMAC(qd2, xkq3, Q2[27].x, 6); DPPFMAC(pd2, xkq3, P2[27].x, 6);
                DPPFMAC(qd3, xkq3, Q2[27].y, 7); DPPFMAC(pd3, xkq3, P2[27].y, 7);
                DPPFMAC(qd0, xkq3, Q2[28].x, 8); DPPFMAC(pd0, xkq3, P2[28].x, 8);
                DPPFMAC(qd1, xkq3, Q2[28].y, 9); DPPFMAC(pd1, xkq3, P2[28].y, 9);
                DPPFMAC(qd2, xkq3, Q2[29].x, 10); DPPFMAC(pd2, xkq3, P2[29].x, 10);
                DPPFMAC(qd3, xkq3, Q2[29].y, 11); DPPFMAC(pd3, xkq3, P2[29].y, 11);
                DPPFMAC(qd0, xkq3, Q2[30].x, 12); DPPFMAC(pd0, xkq3, P2[30].x, 12);
                DPPFMAC(qd1, xkq3, Q2[30].y, 13); DPPFMAC(pd1, xkq3, P2[30].y, 13);
                DPPFMAC(qd2, xkq3, Q2[31].x, 14); DPPFMAC(pd2, xkq3, P2[31].x, 14);
                DPPFMAC(qd3, xkq3, Q2[31].y, 15); DPPFMAC(pd3, xkq3, P2[31].y, 15);
                { const float saq = -((qd0 + qd1) + (qd2 + qd3)), sap = -((pd0 + pd1) + (pd2 + pd3)); saq2 = (f32x2){saq, saq}; sap2 = (f32x2){sap, sap}; }
                __builtin_amdgcn_sched_barrier(0);
                f32x4 d_2 = L4[2], b_2 = L4[34], k_2 = L4[50];
                f32x4 d_3 = L4[3], b_3 = L4[35], k_3 = L4[51];
                asm volatile("s_nop 1" : "+v"(xrq0), "+v"(xrq1), "+v"(xrq2), "+v"(xrq3));
                { const f32x2 bxy = b_0.xy, bzw = b_0.zw;
                Q2[0] = Q2[0] * d_0.xy + (saq2 * bxy + vv2 * k_0.xy); Q2[1] = Q2[1] * d_0.zw + (saq2 * bzw + vv2 * k_0.zw);
                P2[0] = P2[0] * d_0.xy + sap2 * bxy; P2[1] = P2[1] * d_0.zw + sap2 * bzw;
                DPPFMAC(yd0, xrq0, Q2[0].x, 0); DPPFMAC(zd0, xrq0, P2[0].x, 0);
                DPPFMAC(yd1, xrq0, Q2[0].y, 1); DPPFMAC(zd1, xrq0, P2[0].y, 1);
                DPPFMAC(yd2, xrq0, Q2[1].x, 2); DPPFMAC(zd2, xrq0, P2[1].x, 2);
                DPPFMAC(yd3, xrq0, Q2[1].y, 3); DPPFMAC(zd3, xrq0, P2[1].y, 3);
                }
                { const f32x2 bxy = b_1.xy, bzw = b_1.zw;
                Q2[2] = Q2[2] * d_1.xy + (saq2 * bxy + vv2 * k_1.xy); Q2[3] = Q2[3] * d_1.zw + (saq2 * bzw + vv2 * k_1.zw);
                P2[2] = P2[2] * d_1.xy + sap2 * bxy; P2[3] = P2[3] * d_1.zw + sap2 * bzw;
                DPPFMAC(yd0, xrq0, Q2[2].x, 4); DPPFMAC(zd0, xrq0, P2[2].x, 4);
                DPPFMAC(yd1, xrq0, Q2[2].y, 5); DPPFMAC(zd1, xrq0, P2[2].y, 5);
                DPPFMAC(yd2, xrq0, Q2[3].x, 6); DPPFMAC(zd2, xrq0, P2[3].x, 6);
                DPPFMAC(yd3, xrq0, Q2[3].y, 7); DPPFMAC(zd3, xrq0, P2[3].y, 7);
                }
                __builtin_amdgcn_sched_barrier(0);
                f32x4 d_4 = L4[4], b_4 = L4[36], k_4 = L4[52];
                f32x4 d_5 = L4[5], b_5 = L4[37], k_5 = L4[53];
                { const f32x2 bxy = b_2.xy, bzw = b_2.zw;
                Q2[4] = Q2[4] * d_2.xy + (saq2 * bxy + vv2 * k_2.xy); Q2[5] = Q2[5] * d_2.zw + (saq2 * bzw + vv2 * k_2.zw);
                P2[4] = P2[4] * d_2.xy + sap2 * bxy; P2[5] = P2[5] * d_2.zw + sap2 * bzw;
                DPPFMAC(yd0, xrq0, Q2[4].x, 8); DPPFMAC(zd0, xrq0, P2[4].x, 8);
                DPPFMAC(yd1, xrq0, Q2[4].y, 9); DPPFMAC(zd1, xrq0, P2[4].y, 9);
                DPPFMAC(yd2, xrq0, Q2[5].x, 10); DPPFMAC(zd2, xrq0, P2[5].x, 10);
                DPPFMAC(yd3, xrq0, Q2[5].y, 11); DPPFMAC(zd3, xrq0, P2[5].y, 11);
                }
                { const f32x2 bxy = b_3.xy, bzw = b_3.zw;
                Q2[6] = Q2[6] * d_3.xy + (saq2 * bxy + vv2 * k_3.xy); Q2[7] = Q2[7] * d_3.zw + (saq2 * bzw + vv2 * k_3.zw);
                P2[6] = P2[6] * d_3.xy + sap2 * bxy; P2[7] = P2[7] * d_3.zw + sap2 * bzw;
                DPPFMAC(yd0, xrq0, Q2[6].x, 12); DPPFMAC(zd0, xrq0, P2[6].x, 12);
                DPPFMAC(yd1, xrq0, Q2[6].y, 13); DPPFMAC(zd1, xrq0, P2[6].y, 13);
                DPPFMAC(yd2, xrq0, Q2[7].x, 14); DPPFMAC(zd2, xrq0, P2[7].x, 14);
                DPPFMAC(yd3, xrq0, Q2[7].y, 15); DPPFMAC(zd3, xrq0, P2[7].y, 15);
                }
                __builtin_amdgcn_sched_barrier(0);
                f32x4 d_6 = L4[6], b_6 = L4[38], k_6 = L4[54];
                f32x4 d_7 = L4[7], b_7 = L4[39], k_7 = L4[55];
                { const f32x2 bxy = b_4.xy, bzw = b_4.zw;
                Q2[8] = Q2[8] * d_4.xy + (saq2 * bxy + vv2 * k_4.xy); Q2[9] = Q2[9] * d_4.zw + (saq2 * bzw + vv2 * k_4.zw);
                P2[8] = P2[8] * d_4.xy + sap2 * bxy; P2[9] = P2[9] * d_4.zw + sap2 * bzw;
                DPPFMAC(yd0, xrq1, Q2[8].x, 0); DPPFMAC(zd0, xrq1, P2[8].x, 0);
                DPPFMAC(yd1, xrq1, Q2[8].y, 1); DPPFMAC(zd1, xrq1, P2[8].y, 1);
                DPPFMAC(yd2, xrq1, Q2[9].x, 2); DPPFMAC(zd2, xrq1, P2[9].x, 2);
                DPPFMAC(yd3, xrq1, Q2[9].y, 3); DPPFMAC(zd3, xrq1, P2[9].y, 3);
                }
                { const f32x2 bxy = b_5.xy, bzw = b_5.zw;
                Q2[10] = Q2[10] * d_5.xy + (saq2 * bxy + vv2 * k_5.xy); Q2[11] = Q2[11] * d_5.zw + (saq2 * bzw + vv2 * k_5.zw);
                P2[10] = P2[10] * d_5.xy + sap2 * bxy; P2[11] = P2[11] * d_5.zw + sap2 * bzw;
                DPPFMAC(yd0, xrq1, Q2[10].x, 4); DPPFMAC(zd0, xrq1, P2[10].x, 4);
                DPPFMAC(yd1, xrq1, Q2[10].y, 5); DPPFMAC(zd1, xrq1, P2[10].y, 5);
                DPPFMAC(yd2, xrq1, Q2[11].x, 6); DPPFMAC(zd2, xrq1, P2[11].x, 6);
                DPPFMAC(yd3, xrq1, Q2[11].y, 7); DPPFMAC(zd3, xrq1, P2[11].y, 7);
                }
                __builtin_amdgcn_sched_barrier(0);
                f32x4 d_8 = L4[8], b_8 = L4[40], k_8 = L4[56];
                f32x4 d_9 = L4[9], b_9 = L4[41], k_9 = L4[57];
                { const f32x2 bxy = b_6.xy, bzw = b_6.zw;
                Q2[12] = Q2[12] * d_6.xy + (saq2 * bxy + vv2 * k_6.xy); Q2[13] = Q2[13] * d_6.zw + (saq2 * bzw + vv2 * k_6.zw);
                P2[12] = P2[12] * d_6.xy + sap2 * bxy; P2[13] = P2[13] * d_6.zw + sap2 * bzw;
                DPPFMAC(yd0, xrq1, Q2[12].x, 8); DPPFMAC(zd0, xrq1, P2[12].x, 8);
                DPPFMAC(yd1, xrq1, Q2[12].y, 9); DPPFMAC(zd1, xrq1, P2[12].y, 9);
                DPPFMAC(yd2, xrq1, Q2[13].x, 10); DPPFMAC(zd2, xrq1, P2[13].x, 10);
                DPPFMAC(yd3, xrq1, Q2[13].y, 11); DPPFMAC(zd3, xrq1, P2[13].y, 11);
                }
                { const f32x2 bxy = b_7.xy, bzw = b_7.zw;
                Q2[14] = Q2[14] * d_7.xy + (saq2 * bxy + vv2 * k_7.xy); Q2[15] = Q2[15] * d_7.zw + (saq2 * bzw + vv2 * k_7.zw);
                P2[14] = P2[14] * d_7.xy + sap2 * bxy; P2[15] = P2[15] * d_7.zw + sap2 * bzw;
                DPPFMAC(yd0, xrq1, Q2[14].x, 12); DPPFMAC(zd0, xrq1, P2[14].x, 12);
                DPPFMAC(yd1, xrq1, Q2[14].y, 13); DPPFMAC(zd1, xrq1, P2[14].y, 13);
                DPPFMAC(yd2, xrq1, Q2[15].x, 14); DPPFMAC(zd2, xrq1, P2[15].x, 14);
                DPPFMAC(yd3, xrq1, Q2[15].y, 15); DPPFMAC(zd3, xrq1, P2[15].y, 15);
                }
                __builtin_amdgcn_sched_barrier(0);
                f32x4 d_10 = L4[10], b_10 = L4[42], k_10 = L4[58];
                f32x4 d_11 = L4[11], b_11 = L4[43], k_11 = L4[59];
                { const f32x2 bxy = b_8.xy, bzw = b_8.zw;
                Q2[16] = Q2[16] * d_8.xy + (saq2 * bxy + vv2 * k_8.xy); Q2[17] = Q2[17] * d_8.zw + (saq2 * bzw + vv2 * k_8.zw);
                P2[16] = P2[16] * d_8.xy + sap2 * bxy; P2[17] = P2[17] * d_8.zw + sap2 * bzw;
                DPPFMAC(yd0, xrq2, Q2[16].x, 0); DPPFMAC(zd0, xrq2, P2[16].x, 0);
                DPPFMAC(yd1, xrq2, Q2[16].y, 1); DPPFMAC(zd1, xrq2, P2[16].y, 1);
                DPPFMAC(yd2, xrq2, Q2[17].x, 2); DPPFMAC(zd2, xrq2, P2[17].x, 2);
                DPPFMAC(yd3, xrq2, Q2[17].y, 3); DPPFMAC(zd3, xrq2, P2[17].y, 3);
                }
                { const f32x2 bxy = b_9.xy, bzw = b_9.zw;
                Q2[18] = Q2[18] * d_9.xy + (saq2 * bxy + vv2 * k_9.xy); Q2[19] = Q2[19] * d_9.zw + (saq2 * bzw + vv2 * k_9.zw);
                P2[18] = P2[18] * d_9.xy + sap2 * bxy; P2[19] = P2[19] * d_9.zw + sap2 * bzw;
                DPPFMAC(yd0, xrq2, Q2[18].x, 4); DPPFMAC(zd0, xrq2, P2[18].x, 4);
                DPPFMAC(yd1, xrq2, Q2[18].y, 5); DPPFMAC(zd1, xrq2, P2[18].y, 5);
                DPPFMAC(yd2, xrq2, Q2[19].x, 6); DPPFMAC(zd2, xrq2, P2[19].x, 6);
                DPPFMAC(yd3, xrq2, Q2[19].y, 7); DPPFMAC(zd3, xrq2, P2[19].y, 7);
                }
                __builtin_amdgcn_sched_barrier(0);
                f32x4 d_12 = L4[12], b_12 = L4[44], k_12 = L4[60];
                f32x4 d_13 = L4[13], b_13 = L4[45], k_13 = L4[61];
                { const f32x2 bxy = b_10.xy, bzw = b_10.zw;
                Q2[20] = Q2[20] * d_10.xy + (saq2 * bxy + vv2 * k_10.xy); Q2[21] = Q2[21] * d_10.zw + (saq2 * bzw + vv2 * k_10.zw);
                P2[20] = P2[20] * d_10.xy + sap2 * bxy; P2[21] = P2[21] * d_10.zw + sap2 * bzw;
                DPPFMAC(yd0, xrq2, Q2[20].x, 8); DPPFMAC(zd0, xrq2, P2[20].x, 8);
                DPPFMAC(yd1, xrq2, Q2[20].y, 9); DPPFMAC(zd1, xrq2, P2[20].y, 9);
                DPPFMAC(yd2, xrq2, Q2[21].x, 10); DPPFMAC(zd2, xrq2, P2[21].x, 10);
                DPPFMAC(yd3, xrq2, Q2[21].y, 11); DPPFMAC(zd3, xrq2, P2[21].y, 11);
                }
                { const f32x2 bxy = b_11.xy, bzw = b_11.zw;
                Q2[22] = Q2[22] * d_11.xy + (saq2 * bxy + vv2 * k_11.xy); Q2[23] = Q2[23] * d_11.zw + (saq2 * bzw + vv2 * k_11.zw);
                P2[22] = P2[22] * d_11.xy + sap2 * bxy; P2[23] = P2[23] * d_11.zw + sap2 * bzw;
                DPPFMAC(yd0, xrq2, Q2[22].x, 12); DPPFMAC(zd0, xrq2, P2[22].x, 12);
                DPPFMAC(yd1, xrq2, Q2[22].y, 13); DPPFMAC(zd1, xrq2, P2[22].y, 13);
                DPPFMAC(yd2, xrq2, Q2[23].x, 14); DPPFMAC(zd2, xrq2, P2[23].x, 14);
                DPPFMAC(yd3, xrq2, Q2[23].y, 15); DPPFMAC(zd3, xrq2, P2[23].y, 15);
                }
                __builtin_amdgcn_sched_barrier(0);
                f32x4 d_14 = L4[14], b_14 = L4[46], k_14 = L4[62];
                f32x4 d_15 = L4[15], b_15 = L4[47], k_15 = L4[63];
                { const f32x2 bxy = b_12.xy, bzw = b_12.zw;
                Q2[24] = Q2[24] * d_12.xy + (saq2 * bxy + vv2 * k_12.xy); Q2[25] = Q2[25] * d_12.zw + (saq2 * bzw + vv2 * k_12.zw);
                P2[24] = P2[24] * d_12.xy + sap2 * bxy; P2[25] = P2[25] * d_12.zw + sap2 * bzw;
                DPPFMAC(yd0, xrq3, Q2[24].x, 0); DPPFMAC(zd0, xrq3, P2[24].x, 0);
                DPPFMAC(yd1, xrq3, Q2[24].y, 1); DPPFMAC(zd1, xrq3, P2[24].y, 1);
                DPPFMAC(yd2, xrq3, Q2[25].x, 2); DPPFMAC(zd2, xrq3, P2[25].x, 2);
                DPPFMAC(yd3, xrq3, Q2[25].y, 3); DPPFMAC(zd3, xrq3, P2[25].y, 3);
                }
                { const f32x2 bxy = b_13.xy, bzw = b_13.zw;
                Q2[26] = Q2[26] * d_13.xy + (saq2 * bxy + vv2 * k_13.xy); Q2[27] = Q2[27] * d_13.zw + (saq2 * bzw + vv2 * k_13.zw);
                P2[26] = P2[26] * d_13.xy + sap2 * bxy; P2[27] = P2[27] * d_13.zw + sap2 * bzw;
                DPPFMAC(yd0, xrq3, Q2[26].x, 4); DPPFMAC(zd0, xrq3, P2[26].x, 4);
                DPPFMAC(yd1, xrq3, Q2[26].y, 5); DPPFMAC(zd1, xrq3, P2[26].y, 5);
                DPPFMAC(yd2, xrq3, Q2[27].x, 6); DPPFMAC(zd2, xrq3, P2[27].x, 6);
                DPPFMAC(yd3, xrq3, Q2[27].y, 7); DPPFMAC(zd3, xrq3, P2[27].y, 7);
                }
                __builtin_amdgcn_sched_barrier(0);
                { const f32x2 bxy = b_14.xy, bzw = b_14.zw;
                Q2[28] = Q2[28] * d_14.xy + (saq2 * bxy + vv2 * k_14.xy); Q2[29] = Q2[29] * d_14.zw + (saq2 * bzw + vv2 * k_14.zw);
                P2[28] = P2[28] * d_14.xy + sap2 * bxy; P2[29] = P2[29] * d_14.zw + sap2 * bzw;
                DPPFMAC(yd0, xrq3, Q2[28].x, 8); DPPFMAC(zd0, xrq3, P2[28].x, 8);
                DPPFMAC(yd1, xrq3, Q2[28].y, 9); DPPFMAC(zd1, xrq3, P2[28].y, 9);
                DPPFMAC(yd2, xrq3, Q2[29].x, 10); DPPFMAC(zd2, xrq3, P2[29].x, 10);
                DPPFMAC(yd3, xrq3, Q2[29].y, 11); DPPFMAC(zd3, xrq3, P2[29].y, 11);
                }
                { const f32x2 bxy = b_15.xy, bzw = b_15.zw;
                Q2[30] = Q2[30] * d_15.xy + (saq2 * bxy + vv2 * k_15.xy); Q2[31] = Q2[31] * d_15.zw + (saq2 * bzw + vv2 * k_15.zw);
                P2[30] = P2[30] * d_15.xy + sap2 * bxy; P2[31] = P2[31] * d_15.zw + sap2 * bzw;
                DPPFMAC(yd0, xrq3, Q2[30].x, 12); DPPFMAC(zd0, xrq3, P2[30].x, 12);
                DPPFMAC(yd1, xrq3, Q2[30].y, 13); DPPFMAC(zd1, xrq3, P2[30].y, 13);
                DPPFMAC(yd2, xrq3, Q2[31].x, 14); DPPFMAC(zd2, xrq3, P2[31].x, 14);
                DPPFMAC(yd3, xrq3, Q2[31].y, 15); DPPFMAC(zd3, xrq3, P2[31].y, 15);
                }
                __builtin_amdgcn_sched_barrier(0);
                }
                if (!PASS2 && MODE == 0) {
                    const unsigned ox = i0 + (unsigned)((seg * SB + s) * DB);
                    YT[ox] = (yd0 + yd1) + (yd2 + yd3); ZT[ox] = (bf16)f2bf((zd0 + zd1) + (zd2 + zd3));
                }
                if (PASS2) {
                    const f32x2 ys = (yloa + ylob) + (yhia + yhib);
                    const float y = ys.x + ys.y;
                    float s1 = y, s2 = y * y; wave_sum2(s1, s2);
                    const float mean = s1 * (1.0f / 64.0f); const float var = fmaxf(s2 * (1.0f / 64.0f) - mean * mean, 0.f);
                    const float yn = (y - mean) * (1.0f / sqrtf(var + 64e-5f)) * lw + lb;
                    const float o = (yn + sv[7 * 64 + lane] * vv) * sv[6 * 64 + lane];
                    YB[i0 + (unsigned)((seg * SB + s) * DB)] = (bf16)f2bf(o);
                }
            }
            asm volatile("" ::: "memory");
            if (MODE != 2 && seg + 1 < CL / SB) SCAN_STORE(bi ^ 1, seg + 1);
            asm volatile("" ::: "memory");
        }
#undef SCAN_LOAD
#undef SCAN_STORE
        if (MODE != 0) { float acc_ = 0.f; _Pragma("unroll") for (int k = 0; k < 32; ++k) acc_ += Q2[k].x + Q2[k].y + P2[k].x + P2[k].y; if (acc_ == 123.456f) ST[0] = acc_; }
        if (!PASS2 && MODE == 0) { f32x4* sq = (f32x4*)(ST + ((size_t)u * 2) * 4096 + lane * 64); f32x4* sp = (f32x4*)(ST + ((size_t)u * 2 + 1) * 4096 + lane * 64);
#pragma unroll
            for (int j = 0; j < 16; ++j) { sq[j] = (f32x4){Q2[2 * j].x, Q2[2 * j].y, Q2[2 * j + 1].x, Q2[2 * j + 1].y}; sp[j] = (f32x4){P2[2 * j].x, P2[2 * j].y, P2[2 * j + 1].x, P2[2 * j + 1].y}; } }
    }
}

#define DPPR(v, ctrl) __int_as_float(__builtin_amdgcn_update_dpp(0, __float_as_int(v), ctrl, 0xf, 0xf, false))
__device__ __forceinline__ float row16_allsum(float v) { v += DPPR(v, 0xB1); v += DPPR(v, 0x4E); v += DPPR(v, 0x141); v += DPPR(v, 0x140); return v; }
struct P2Tile { u32x4 z0, z1; f32x4 yt[4]; u32x2 vv[4], gg[4]; float bo; };
__device__ __forceinline__ void phase_scan2z(const Params& p) {
    const int tid = threadIdx.x, lane = tid & 63, wave = tid >> 6, G = gridDim.x;
    const int gw = blockIdx.x * NWAVES + wave, NGW = G * NWAVES;
    unsigned char* ws = p.ws;
    const bf16* V = (const bf16*)p.out + (size_t)2 * T * DB; const bf16* Gt = (const bf16*)(ws + WS_G); const float* BON = (const float*)(ws + WS_BONUS); bf16* YB = (bf16*)(ws + WS_YB);
    const float* ST = (const float*)(ws + WS_ST); const float* YT = (const float*)p.out; const bf16* ZT = (const bf16*)p.out + (size_t)3 * T * DB;
    for (int u = gw; u < 32 * NCH; u += NGW) {
        const int bh = u / NCH, ch = u % NCH, b = bh >> 4, h = bh & 15; int lnl = lane; asm volatile("" : "+v"(lnl));
        const int lr = lnl & 15, lq = lnl >> 4;
        const unsigned t00 = (unsigned)(b * SEQ + ch * CL);
        bf16x8 Sf[4][2];
#pragma unroll
        for (int c = 0; c < 4; ++c)
#pragma unroll
            for (int ks = 0; ks < 2; ++ks) { u32x4 w = (u32x4){0u, 0u, 0u, 0u};
                if (ch > 0) { const float* sp = ST + ((size_t)(u - 1) * 2) * 4096 + (16 * c + lr) * 64 + 32 * ks + 8 * lq; const f32x4 x0 = *(const f32x4*)sp, x1 = *(const f32x4*)(sp + 4);
                    w.x = pk2(x0[0], x0[1]); w.y = pk2(x0[2], x0[3]); w.z = pk2(x1[0], x1[1]); w.w = pk2(x1[2], x1[3]); }
                Sf[c][ks] = __builtin_bit_cast(bf16x8, w); }
        f32x4 lw[4], lb[4];
#pragma unroll
        for (int c = 0; c < 4; ++c) { lw[c] = *(const f32x4*)(p.in[I_LNW] + h * 64 + 16 * c + 4 * lq); lb[c] = *(const f32x4*)(p.in[I_LNB] + h * 64 + 16 * c + 4 * lq); }
#define P2_LOAD(D, tt) do { const unsigned ta_ = t00 + 16u * (tt) + lr; const bf16* zp_ = ZT + (size_t)ta_ * DB + h * 64 + 8 * lq; (D).z0 = *(const u32x4*)zp_; (D).z1 = *(const u32x4*)(zp_ + 32); \
            const size_t o_ = (size_t)ta_ * DB + h * 64 + 4 * lq; (D).bo = BON[ta_ * NH + h]; \
            _Pragma("unroll") for (int c = 0; c < 4; ++c) { (D).yt[c] = *(const f32x4*)(YT + o_ + 16 * c); (D).vv[c] = *(const u32x2*)(V + o_ + 16 * c); (D).gg[c] = *(const u32x2*)(Gt + o_ + 16 * c); } } while (0)
#define P2_COMP(D, tt) do { f32x4 y_[4]; const bf16x8 b0_ = __builtin_bit_cast(bf16x8, (D).z0), b1_ = __builtin_bit_cast(bf16x8, (D).z1); float s1_ = 0.f, s2_ = 0.f; \
            _Pragma("unroll") for (int c = 0; c < 4; ++c) { f32x4 a_ = __builtin_amdgcn_mfma_f32_16x16x32_bf16(Sf[c][0], b0_, (f32x4){0.f, 0.f, 0.f, 0.f}, 0, 0, 0); a_ = __builtin_amdgcn_mfma_f32_16x16x32_bf16(Sf[c][1], b1_, a_, 0, 0, 0); \
                y_[c] = a_ + (D).yt[c]; s1_ += (y_[c][0] + y_[c][1]) + (y_[c][2] + y_[c][3]); s2_ += (y_[c][0] * y_[c][0] + y_[c][1] * y_[c][1]) + (y_[c][2] * y_[c][2] + y_[c][3] * y_[c][3]); } \
            s1_ += __shfl_xor(s1_, 16); s2_ += __shfl_xor(s2_, 16); s1_ += __shfl_xor(s1_, 32); s2_ += __shfl_xor(s2_, 32); \
            const float mean_ = s1_ * (1.0f / 64.0f), rs_ = 1.0f / sqrtf(fmaxf(s2_ * (1.0f / 64.0f) - mean_ * mean_, 0.f) + 64e-5f); \
            const size_t o_ = (size_t)(t00 + 16u * (tt) + lr) * DB + h * 64 + 4 * lq; \
            _Pragma("unroll") for (int c = 0; c < 4; ++c) { const u32x2 vw_ = (D).vv[c], gw_ = (D).gg[c]; \
                const f32x4 v4_ = (f32x4){__uint_as_float(vw_.x << 16), __uint_as_float(vw_.x & 0xffff0000u), __uint_as_float(vw_.y << 16), __uint_as_float(vw_.y & 0xffff0000u)}; \
                const f32x4 g4_ = (f32x4){__uint_as_float(gw_.x << 16), __uint_as_float(gw_.x & 0xffff0000u), __uint_as_float(gw_.y << 16), __uint_as_float(gw_.y & 0xffff0000u)}; \
                const f32x4 o4_ = ((y_[c] - mean_) * rs_ * lw[c] + lb[c] + v4_ * (D).bo) * g4_; u32x2 w_; w_.x = pk2(o4_[0], o4_[1]); w_.y = pk2(o4_[2], o4_[3]); *(u32x2*)(YB + o_ + 16 * c) = w_; } } while (0)
        P2Tile A, B;
        P2_LOAD(A, 0);
#pragma unroll 1
        for (int tt = 0; tt < CL / 16; tt += 2) {
            P2_LOAD(B, tt + 1);
            P2_COMP(A, tt);
            if (tt + 2 < CL / 16) P2_LOAD(A, tt + 2);
            P2_COMP(B, tt + 1);
        }
#undef P2_LOAD
#undef P2_COMP
    }
}

__device__ __forceinline__ void phase_combine(const Params& p, LAS unsigned char* lds) {
    const int tid = threadIdx.x, lane = tid & 63, wave = tid >> 6, G = gridDim.x;
    float* ST = (float*)(p.ws + WS_ST);
    LAS float* PL = (LAS float*)lds;
    if (G > 128 && (int)blockIdx.x >= 128) { convert_weights<1>(p, lds, ((int)blockIdx.x - 128) * NWAVES + wave, (G - 128) * NWAVES); return; }
    for (int bu = blockIdx.x; bu < 32 * 4; bu += G) {
        const int bh = bu >> 2, rq = bu & 3, r0 = rq * 16 + wave * 2;
        const float* base = ST + ((size_t)(bh * NCH) * 2) * 4096;
        float s0 = base[(r0) * 64 + lane], s1 = base[(r0 + 1) * 64 + lane];
        f32x4 pr0, pr1; float q0n, q1n;
        __syncthreads();
        { const f32x4* pp = (const f32x4*)(base + 1 * 8192 + 4096); pr0 = pp[tid]; pr1 = pp[tid + 512]; q0n = base[1 * 8192 + (r0) * 64 + lane]; q1n = base[1 * 8192 + (r0 + 1) * 64 + lane]; }
        *(LAS f32x4*)(PL + 4096 + tid * 4) = pr0; *(LAS f32x4*)(PL + 4096 + (tid + 512) * 4) = pr1;
        __syncthreads();
        for (int c = 1; c < NCH - 1; ++c) {
            const LAS float* Pc = PL + (c & 1) * 4096;
            float n0 = q0n, n1 = q1n;
            if (c + 1 < NCH - 1) { const f32x4* pp = (const f32x4*)(base + (size_t)(c + 1) * 8192 + 4096); pr0 = pp[tid]; pr1 = pp[tid + 512];
                q0n = base[(size_t)(c + 1) * 8192 + (r0) * 64 + lane]; q1n = base[(size_t)(c + 1) * 8192 + (r0 + 1) * 64 + lane]; }
            float a0 = 0.f, a1 = 0.f, b0 = 0.f, b1 = 0.f;
#pragma unroll
            for (int k = 0; k < 64; k += 2) { const float pk0 = Pc[k * 64 + lane], pk1 = Pc[(k + 1) * 64 + lane];
                a0 += __int_as_float(__builtin_amdgcn_readlane(__float_as_int(s0), k)) * pk0; b0 += __int_as_float(__builtin_amdgcn_readlane(__float_as_int(s0), k + 1)) * pk1;
                a1 += __int_as_float(__builtin_amdgcn_readlane(__float_as_int(s1), k)) * pk0; b1 += __int_as_float(__builtin_amdgcn_readlane(__float_as_int(s1), k + 1)) * pk1; }
            s0 = n0 + (a0 + b0); s1 = n1 + (a1 + b1);
            float* Qc = ST + ((size_t)(bh * NCH + c) * 2) * 4096;
            Qc[(r0) * 64 + lane] = s0; Qc[(r0 + 1) * 64 + lane] = s1;
            if (c + 1 < NCH - 1) { LAS float* Pn = PL + ((c + 1) & 1) * 4096; *(LAS f32x4*)(Pn + tid * 4) = pr0; *(LAS f32x4*)(Pn + (tid + 512) * 4) = pr1; }
            __syncthreads();
        }
    }
}

__device__ __forceinline__ void phase_fixup(const Params& p) {
    const int tid = threadIdx.x, G = gridDim.x; unsigned char* ws = p.ws;
    const float* TOP = (const float*)(ws + WS_TOP); const float* BOT = (const float*)(ws + WS_BOT); bf16* ACT = (bf16*)(ws + WS_ACT);
    const float* cw = p.in[I_CW];
    const int gt = blockIdx.x * NTHR + tid, NGT = G * NTHR;
    for (int i0 = gt; i0 < 128 * 2 * DFF; i0 += 4 * NGT) {
        float Cg[4], Cv[4], bg0[4], bg1[4], bv0[4], bv1[4];
#pragma unroll
        for (int u = 0; u < 4; ++u) { const int i = i0 + u * NGT; Cg[u] = Cv[u] = bg0[u] = bg1[u] = bv0[u] = bv1[u] = 0.f;
            if (i < 128 * 2 * DFF) { const int j = i % DFF, row = (i / DFF) & 1, pm = i / (2 * DFF); const int cg_ = (j >> 7) * 256 + (j & 127), cv_ = cg_ + 128;
                Cg[u] = TOP[((size_t)pm * 2 + row) * 11264 + cg_]; Cv[u] = TOP[((size_t)pm * 2 + row) * 11264 + cv_];
                if (pm % 64) { const float* b0 = BOT + ((size_t)(pm - 1) * 2) * 11264; const float* b1 = b0 + 11264; bg0[u] = b0[cg_]; bg1[u] = b1[cg_]; bv0[u] = b0[cv_]; bv1[u] = b1[cv_]; } } }
#pragma unroll
        for (int u = 0; u < 4; ++u) { const int i = i0 + u * NGT;
            if (i < 128 * 2 * DFF) { const int j = i % DFF, row = (i / DFF) & 1, pm = i / (2 * DFF); float g = Cg[u], v = Cv[u];
                if (pm % 64) { if (row == 0) { g += cw[j] * bg0[u] + cw[11264 + j] * bg1[u]; v += cw[5632 + j] * bv0[u] + cw[11264 + 5632 + j] * bv1[u]; }
                               else { g += cw[j] * bg1[u]; v += cw[5632 + j] * bv1[u]; } }
                ACT[(size_t)(pm * 256 + row) * DFF + j] = (bf16)f2bf(gelu_f(g) * v); } } }
}

__device__ __forceinline__ void phase_final(const Params& p) {
    const int tid = threadIdx.x, lane = tid & 63, wave = tid >> 6, G = gridDim.x;
    const int gw = blockIdx.x * NWAVES + wave, NGW = G * NWAVES;
    const float* ssq = (const float*)(p.ws + WS_SSQ2); const f32x4* gr = (const f32x4*)p.in[I_NFG] + lane;
    f32x4 g4[8];
#pragma unroll
    for (int j = 0; j < 8; ++j) g4[j] = gr[64 * j];
    constexpr int UR = 4;
    for (int row0 = gw; row0 < T; row0 += UR * NGW) { f32x4 v[UR][8]; float rs[UR];
#pragma unroll
        for (int u = 0; u < UR; ++u) { const int row = row0 + u * NGW; const f32x4* xr = (const f32x4*)(p.out + (size_t)row * DM) + lane;
#pragma unroll
            for (int j = 0; j < 8; ++j) v[u][j] = xr[64 * j];
            const f32x4* sp = (const f32x4*)(ssq + (size_t)row * 32); f32x4 s = sp[0];
#pragma unroll
            for (int i = 1; i < 8; ++i) s += sp[i];
            rs[u] = 1.0f / sqrtf(((s[0] + s[1]) + (s[2] + s[3])) * (1.0f / DM) + 1e-6f); }
#pragma unroll
        for (int u = 0; u < UR; ++u) { f32x4* xr = (f32x4*)(p.out + (size_t)(row0 + u * NGW) * DM) + lane;
#pragma unroll
            for (int j = 0; j < 8; ++j) __builtin_nontemporal_store(v[u][j] * rs[u] * g4[j], xr + 64 * j); } }
}

#define XB_TMO      128
#define XB_XCNT(j)  (256  + 64 * (j))
#define XB_XSUB(j)  (1280 + 64 * (j))
#define XB_XGEN(j)  (2304 + 64 * (j))
#define XB_TOP      3328
#define XB_TOPGEN   3392
#define XCD_BAR_WORDS 3456
#define XB_SPIN_CAP (1u << 18)

__device__ __forceinline__ unsigned xb_ld(unsigned* p)              { return __hip_atomic_load(p, __ATOMIC_RELAXED, __HIP_MEMORY_SCOPE_AGENT); }
__device__ __forceinline__ unsigned xb_add(unsigned* p, unsigned v) { return __hip_atomic_fetch_add(p, v, __ATOMIC_RELAXED, __HIP_MEMORY_SCOPE_AGENT); }
__device__ __forceinline__ unsigned xb_xcc_id() { return (unsigned)__builtin_amdgcn_s_getreg((3 << 11) | 20) & 0xFu; }
#define XB_SPIN(cond, bar) do { unsigned _sp = 0; while (cond) { __builtin_amdgcn_s_sleep(1); \
    if ((++_sp & 255u) == 0u) { if (xb_ld(&(bar)[XB_TMO])) break; if (_sp > XB_SPIN_CAP) { atomicAdd(&(bar)[XB_TMO], 1u); break; } } } } while (0)

struct XcdBarrier {
    unsigned* bar; unsigned x;
    volatile LAS unsigned* st;
};

__device__ __forceinline__ XcdBarrier xcd_barrier_post(unsigned* bar, volatile LAS unsigned* st) {
    XcdBarrier b; b.bar = bar; b.x = xb_xcc_id(); b.st = st;
    if (threadIdx.x == 0) (void)xb_add(&bar[XB_XCNT(b.x)], 1u);
    return b;
}
__device__ __forceinline__ void xcd_barrier_complete(unsigned* bar, unsigned x, unsigned& nloc, unsigned& nx) {
    const unsigned G = gridDim.x * gridDim.y * gridDim.z;
    unsigned sum, cnt, mine, sp = 0u;
    for (;;) {
        sum = 0u; cnt = 0u; mine = 0u;
#pragma unroll
        for (unsigned j = 0; j < 16; ++j) { const unsigned c = xb_ld(&bar[XB_XCNT(j)]); sum += c; cnt += (c > 0u) ? 1u : 0u; mine = (j == x) ? c : mine; }
        if (sum == G) break;
        __builtin_amdgcn_s_sleep(1);
        if ((++sp & 255u) == 0u) { if (xb_ld(&bar[XB_TMO])) break; if (sp > XB_SPIN_CAP) { atomicAdd(&bar[XB_TMO], 1u); break; } }
    }
    nloc = mine > 0u ? mine : 1u; nx = cnt > 0u ? cnt : 1u;
}

__device__ __forceinline__ void xcd_barrier(const XcdBarrier& b) {
    asm volatile("s_waitcnt vmcnt(0)" ::: "memory");
    __syncthreads();
    if (threadIdx.x == 0) {
        unsigned* bar = b.bar;
        __builtin_amdgcn_s_waitcnt(0);
        unsigned nloc = b.st[0], nx = b.st[1];
        if (nloc == 0u) { xcd_barrier_complete(bar, b.x, nloc, nx); b.st[0] = nloc; b.st[1] = nx; }
        const unsigned old = xb_add(&bar[XB_XSUB(b.x)], 1u);
        const unsigned gen = old / nloc;
        if (old + 1u == (gen + 1u) * nloc) {
            __builtin_amdgcn_fence(__ATOMIC_RELEASE, "agent");
            asm volatile("s_waitcnt vmcnt(0)" ::: "memory");
            const unsigned og = xb_add(&bar[XB_TOP], 1u);
            const unsigned tg = og / nx;
            if (og + 1u == (tg + 1u) * nx) xb_add(&bar[XB_TOPGEN], 1u);
            else XB_SPIN(xb_ld(&bar[XB_TOPGEN]) == tg, bar);
            __builtin_amdgcn_fence(__ATOMIC_ACQUIRE, "agent");
            xb_add(&bar[XB_XGEN(b.x)], 1u);
            asm volatile("s_waitcnt vmcnt(0)" ::: "memory");
        } else {
            XB_SPIN(xb_ld(&bar[XB_XGEN(b.x)]) == gen, bar);
            __builtin_amdgcn_fence(__ATOMIC_ACQUIRE, "agent");
            asm volatile("s_waitcnt vmcnt(0)" ::: "memory");
        }
    }
    __syncthreads();
}

constexpr int N_PHASES = 15;
__global__ void __launch_bounds__(NTHR, 2) fwd_kernel(Params p) {
    extern __shared__ __attribute__((aligned(16))) unsigned char lds_raw[];
    LAS unsigned char* lds = (LAS unsigned char*)lds_raw;
    cg::grid_group grid = cg::this_grid();
    unsigned char* ws = p.ws; const int G = gridDim.x, bx = blockIdx.x;
    const float* rstd1 = (const float*)(ws + WS_RSTD1);
#define IN(k) (p.ph_lo <= (k) && (k) < p.ph_hi)
    for (int u_ = threadIdx.x; u_ < 256; u_ += NTHR) ((LAS unsigned*)(lds + 143360))[u_] = 0u;
    __syncthreads();
    XcdBarrier xbar = xcd_barrier_post((unsigned*)(ws + WS_BAR), (volatile LAS unsigned*)(lds + 143360 + 64));
#define SEAM(k) do { if (IN(k) && IN((k) + 1)) { if ((k) == 0) grid.sync(); else xcd_barrier(xbar); } } while (0)
#ifndef PROBE_DUP
#define PROBE_DUP 0
#endif
#define PH(k) if (IN(k)) for (int rep_ = 0; rep_ <= ((PROBE_DUP >> (k)) & 1); ++rep_)
    PH(0) { if (rep_) xcd_barrier(xbar); phase_prologue(p, lds); } SEAM(0);
    PH(1) { if (rep_) xcd_barrier(xbar); pg8::Gemm g{(const bf16*)(ws + WS_XB), (const bf16*)(ws + WS_W_IN), T, N_IN1, DM}; pg8::StaticOrder S; S.init(T, N_IN1, G, bx);
        pg8::EpiIn E{(bf16*)(ws + WS_AU), (bf16*)(ws + WS_AV), (bf16*)(ws + WS_FEAT), (bf16*)(ws + WS_LRAW), rstd1, (float*)(ws + WS_SSQ2)};
        pg8::gemm_phase<pg8::EpiIn, pg8::StaticOrder, true, true>(lds, g, S, E); } SEAM(1);
    PH(2) { if (rep_) xcd_barrier(xbar); phase_gmlp(p, lds); } SEAM(2);
    PH(3) { if (rep_) xcd_barrier(xbar); int kl = K_LORA; asm volatile("" : "+s"(kl)); pg8::Gemm g{(const bf16*)(ws + WS_LIN), (const bf16*)(ws + WS_W_LORA), T, N_LORA, kl}; pg8::StaticOrder S; S.init(T, N_LORA, G, bx);
        pg8::EpiLora E{(float*)(ws + WS_DEC), (bf16*)(ws + WS_AS), (bf16*)(ws + WS_G), p.in[I_W0], p.in[I_A0]};
        pg8::gemm_phase<pg8::EpiLora, pg8::StaticOrder, true, true>(lds, g, S, E); } SEAM(3);
    PH(5) { if (rep_) xcd_barrier(xbar); phase_scan<false>(p, lds); } SEAM(5);
    PH(6) { if (rep_) xcd_barrier(xbar); phase_combine(p, lds); } SEAM(6);
    PH(7) { if (rep_) xcd_barrier(xbar); phase_scan2z(p); } SEAM(7);
    PH(8) { if (rep_) xcd_barrier(xbar);
        { pg8::Gemm g{(const bf16*)(ws + WS_XB), (const bf16*)(ws + WS_W_IN) + (size_t)N_IN1 * DM, T, N_GATE, DM}; pg8::StaticOrder S; S.init(T, N_GATE, G, bx);
          pg8::EpiGate E{(bf16*)p.out, rstd1};
          pg8::gemm_phase<pg8::EpiGate, pg8::StaticOrder, true, true>(lds, g, S, E); }
        { pg8::Gemm g{(const bf16*)(ws + WS_YA), (const bf16*)(ws + WS_W_PA), T, DM, DA}; pg8::StaticOrder S; S.init(T, DM, G, bx);
          pg8::EpiPlain E{(bf16*)(ws + WS_PA)};
          pg8::gemm_phase<pg8::EpiPlain, pg8::StaticOrder, true, true>(lds, g, S, E); } } SEAM(8);
    PH(9) { if (rep_) xcd_barrier(xbar); pg8::Gemm g{(const bf16*)(ws + WS_YB), (const bf16*)(ws + WS_W_PB), T, DM, DB}; pg8::StaticOrder S; S.init(T, DM, G, bx);
        pg8::EpiMerge E{(const bf16*)p.out, (const bf16*)(ws + WS_PA), (bf16*)(ws + WS_MERGED)};
        pg8::gemm_phase<pg8::EpiMerge, pg8::StaticOrder, true, true>(lds, g, S, E); } SEAM(9);
    PH(10) { if (rep_) xcd_barrier(xbar); pg8::Gemm g{(const bf16*)(ws + WS_MERGED), (const bf16*)(ws + WS_W_OUT), T, DM, DM}; pg8::StaticOrder S; S.init(T, DM, G, bx);
        pg8::EpiRes<false> E{(const bf16*)(ws + WS_XB), nullptr, (bf16*)(ws + WS_XB), (float*)(ws + WS_SSQ1)};
        pg8::gemm_phase<pg8::EpiRes<false>, pg8::StaticOrder, true, true>(lds, g, S, E); } SEAM(10);
    PH(11) { if (rep_) xcd_barrier(xbar); pg8::Gemm g{(const bf16*)(ws + WS_XB), (const bf16*)(ws + WS_W_UP), T, 2 * DFF, DM}; pg8::StaticOrder S; S.init(T, 2 * DFF, G, bx);
        pg8::EpiUp E{(bf16*)(ws + WS_ACT), (const float*)(ws + WS_SSQ1), p.in[I_CW], p.in[I_CB], (float*)(ws + WS_TOP), (float*)(ws + WS_BOT), lds + EPI_OFF};
        pg8::gemm_phase<pg8::EpiUp, pg8::StaticOrder, true, true>(lds, g, S, E); } SEAM(11);
    PH(12) { if (rep_) xcd_barrier(xbar); phase_fixup(p); } SEAM(12);
    PH(13) { if (rep_) xcd_barrier(xbar); pg8::Gemm g{(const bf16*)(ws + WS_ACT), (const bf16*)(ws + WS_W_DOWN), T, DM, DFF}; pg8::StaticOrder S; S.init(T, DM, G, bx);
        pg8::EpiRes<true> E{(const bf16*)(ws + WS_XB), p.out, nullptr, (float*)(ws + WS_SSQ2)};
        pg8::gemm_phase<pg8::EpiRes<true>, pg8::StaticOrder, true, true>(lds, g, S, E); } SEAM(13);
    PH(14) { if (rep_) xcd_barrier(xbar); phase_final(p); }
#undef IN
#undef PH
#undef SEAM
}

#ifndef MK_PER_PHASE
#define MK_PER_PHASE 0
#endif
extern "C" void kernel_launch(void* const* d_in, const int* in_sizes, int n_in, void* d_out, int out_size, void* d_ws, size_t ws_size, hipStream_t stream) {
    static int grid = 0;
    if (grid == 0) {
        if (n_in != 27 || out_size != T * DM || ws_size < WS_END) { fprintf(stderr, "kernel_launch: unexpected shapes (n_in %d, out %d, ws %zu < %zu)\n", n_in, out_size, ws_size, (size_t)WS_END); grid = -1; return; }
        int dev = 0, cus = 0, per_cu = 0;
        hipGetDevice(&dev); hipDeviceGetAttribute(&cus, hipDeviceAttributeMultiprocessorCount, dev);
        hipFuncSetAttribute((const void*)fwd_kernel, hipFuncAttributeMaxDynamicSharedMemorySize, LDS_BYTES);
        hipOccupancyMaxActiveBlocksPerMultiprocessor(&per_cu, (const void*)fwd_kernel, NTHR, LDS_BYTES);
        if (per_cu < 1) { fprintf(stderr, "kernel_launch: occupancy query says %d blocks per CU\n", per_cu); per_cu = 1; }
        (void)hipGetLastError();
        grid = cus;
    }
    if (grid < 0) return;
    Params p{};
    for (int i = 0; i < 27; ++i) p.in[i] = (const float*)d_in[i];
    p.out = (float*)d_out; p.ws = (unsigned char*)d_ws;
#if MK_PER_PHASE
    for (int ph = 0; ph < N_PHASES; ++ph) { p.ph_lo = ph; p.ph_hi = ph + 1; hipLaunchKernelGGL(fwd_kernel, dim3(grid), dim3(NTHR), LDS_BYTES, stream, p); }
#else
    p.ph_lo = 0; p.ph_hi = N_PHASES;
    if (hipMemsetAsync((char*)d_ws + WS_BAR, 0, BAR_BYTES, stream) != hipSuccess) { fprintf(stderr, "kernel_launch: memset of barrier words failed\n"); return; }
    void* args[] = {&p};
    hipError_t e = hipLaunchCooperativeKernel((const void*)fwd_kernel, dim3(grid), dim3(NTHR), args, LDS_BYTES, stream);
    if (e != hipSuccess) fprintf(stderr, "cooperative launch failed: %s (grid %d)\n", hipGetErrorString(e), grid);
#endif
}
```

```cpp
#include <hip/hip_runtime.h>
#include <cstdio>
#include <cstdint>
namespace pg8 {
#define PG8_LAS __attribute__((address_space(3)))
typedef unsigned short bf16_t;
typedef short bf16x8 __attribute__((ext_vector_type(8)));
typedef float f32x4 __attribute__((ext_vector_type(4)));
typedef unsigned u32x4 __attribute__((ext_vector_type(4)));
constexpr int BM = 256, BK = 64, HALF = 128, HTB = HALF * BK * 2  , STAGE_BYTES = 8 * HTB, NXCD = 8, WGM = 8;

__host__ __device__ __forceinline__ int lds_byte(int r, int c) { const int st = (r >> 4) * 2 + (c >> 5), rr = r & 15, cc = c & 31, ob = rr * 64 + cc * 2; return st * 1024 + (ob ^ (((ob >> 9) & 1) << 5)); }
__host__ __device__ __forceinline__ void stage_rc(int b, int& R, int& C) { const int st = b / 1024, sb = b % 1024, swz = sb ^ (((sb >> 9) & 1) << 5); R = (st >> 1) * 16 + swz / 64; C = (st & 1) * 32 + (swz % 64) / 2; }
__host__ __device__ __forceinline__ int perm32(int rho) { const int n = rho >> 4, i = rho & 15; return 8 * (i >> 2) + 4 * n + (i & 3); }

struct Unit { int pm, pn; };
struct Gemm { const bf16_t* A; const bf16_t* Bt; int M, N, K; };

struct StaticOrder {
    int nM, nN, nwg, G, c;
    __host__ __device__ void init(int M, int N, int G_, int c_) { nM = M / BM; nN = N / BM; nwg = nM * nN; G = G_; c = c_; }
    __host__ __device__ bool next(int i, Unit& u) const {
        const long L = (long)i * G + c; if (L >= nwg) return false;
        int wgid = (int)L; { const int q = nwg / NXCD, r = nwg % NXCD, xcd = wgid % NXCD, off = wgid / NXCD; wgid = (xcd < r ? xcd * (q + 1) : r * (q + 1) + (xcd - r) * q) + off; }
        const int nig = WGM * nN, gid = wgid / nig, fm = gid * WGM, gsz = (nM - fm) < WGM ? (nM - fm) : WGM;
        u.pm = fm + ((wgid % nig) % gsz); u.pn = (wgid % nig) / gsz; return true;
    }
    __device__ __forceinline__ void a_ready(const Unit&) const {}
    __device__ __forceinline__ void done(const Unit&) const {}
};

typedef float cvt_f32x2_t __attribute__((ext_vector_type(2))); typedef __bf16 cvt_bf16x2_t __attribute__((ext_vector_type(2)));
__device__ __forceinline__ unsigned cvt_pk_bf16(float lo, float hi) { const cvt_f32x2_t v = {lo, hi}; const cvt_bf16x2_t b = __builtin_convertvector(v, cvt_bf16x2_t); return __builtin_bit_cast(unsigned, b); }
typedef float f32x2 __attribute__((ext_vector_type(2)));
__device__ __forceinline__ f32x2 gelu_pk(f32x2 v) {
    const f32x2 av = __builtin_elementwise_abs(v), d = av * 0.2316418882f + 1.0f;
    f32x2 t; t.x = __builtin_amdgcn_rcpf(d.x); t.y = __builtin_amdgcn_rcpf(d.y);
    f32x2 q = t * 0.5307027145f + (-0.7265760135f); q = q * t + 0.7107068705f; q = q * t + (-0.142248368f); q = q * t + 0.127414796f; q = q * t;
    const f32x2 s = (v * v) * (-0.72134752044f);
    f32x2 e; e.x = __builtin_amdgcn_exp2f(s.x); e.y = __builtin_amdgcn_exp2f(s.y);
    const f32x2 m = v * (q * e), r = v - m;
    f32x2 o; o.x = v.x < 0.f ? m.x : r.x; o.y = v.y < 0.f ? m.y : r.y; return o;
}

template <int ACT  > struct EpiBf16 {
    static constexpr bool PERM = true, AFTER_DRAIN = false; static_assert(ACT == 0 || ACT == 1, "EpiBf16: ACT is 0 (none) or 1 (gelu_pk)");
    bf16_t* O; int ldc; const float* bias; int split_cols; size_t split_stride; float scale0;
    __device__ __forceinline__ void operator()(const f32x4 (&acc)[2][2][4][2], const Unit& u, int wr, int wc, int fr, int fq) const {
        const int row0 = u.pm * BM + wr * 64 + fr; int colt = u.pn * BM; bf16_t* base = O;
        float sc = 1.f; if (split_cols) { const int t = colt / split_cols; base += (size_t)t * split_stride; colt -= t * split_cols; if (t == 0) sc = scale0; }
        const int col0 = colt + wc * 32 + 8 * fq, bcol0 = u.pn * BM + wc * 32 + 8 * fq;
        f32x4 bv[2][2];
#pragma unroll
        for (int bj = 0; bj < 2; ++bj)
#pragma unroll
            for (int n = 0; n < 2; ++n) bv[bj][n] = bias ? *(const f32x4*)(bias + bcol0 + bj * HALF + 4 * n) : (f32x4){0.f, 0.f, 0.f, 0.f};
#pragma unroll
        for (int ai = 0; ai < 2; ++ai)
#pragma unroll
            for (int m = 0; m < 4; ++m) { bf16_t* rowp = base + (size_t)(row0 + ai * HALF + m * 16) * ldc + col0;
#pragma unroll
                for (int bj = 0; bj < 2; ++bj) { f32x4 v0 = acc[ai][bj][m][0] + bv[bj][0], v1 = acc[ai][bj][m][1] + bv[bj][1];
                    if (ACT == 1) { f32x2 a = gelu_pk((f32x2){v0[0], v0[1]}), b = gelu_pk((f32x2){v0[2], v0[3]}), c = gelu_pk((f32x2){v1[0], v1[1]}), d = gelu_pk((f32x2){v1[2], v1[3]});
                        v0 = (f32x4){a.x, a.y, b.x, b.y}; v1 = (f32x4){c.x, c.y, d.x, d.y}; }
                    v0 = v0 * sc; v1 = v1 * sc; u32x4 w; w.x = cvt_pk_bf16(v0[0], v0[1]); w.y = cvt_pk_bf16(v0[2], v0[3]); w.z = cvt_pk_bf16(v1[0], v1[1]); w.w = cvt_pk_bf16(v1[2], v1[3]);
                    *(u32x4*)(rowp + bj * HALF) = w; } }
    }
};

__device__ __forceinline__ float sigm(float x) { return __builtin_amdgcn_rcpf(1.0f + __expf(-x)); }
__device__ __forceinline__ float bf2f(unsigned short h) { return __uint_as_float(((unsigned)h) << 16); }
__device__ __forceinline__ u32x4 pack8(f32x4 v0, f32x4 v1) { u32x4 w; w.x = cvt_pk_bf16(v0[0], v0[1]); w.y = cvt_pk_bf16(v0[2], v0[3]); w.z = cvt_pk_bf16(v1[0], v1[1]); w.w = cvt_pk_bf16(v1[2], v1[3]); return w; }
__device__ __forceinline__ void unpack8(u32x4 w, f32x4& v0, f32x4& v1) {
    v0[0] = __uint_as_float(w.x << 16); v0[1] = __uint_as_float(w.x & 0xffff0000u); v0[2] = __uint_as_float(w.y << 16); v0[3] = __uint_as_float(w.y & 0xffff0000u);
    v1[0] = __uint_as_float(w.z << 16); v1[1] = __uint_as_float(w.z & 0xffff0000u); v1[2] = __uint_as_float(w.w << 16); v1[3] = __uint_as_float(w.w & 0xffff0000u); }
__device__ __forceinline__ f32x4 gelu4(f32x4 v) { f32x2 a = gelu_pk((f32x2){v[0], v[1]}), b = gelu_pk((f32x2){v[2], v[3]}); return (f32x4){a.x, a.y, b.x, b.y}; }

struct EpiIn {
    static constexpr bool PERM = true, AFTER_DRAIN = false;
    bf16_t *AU, *AV, *FEAT, *LRAW; const float* rstd; float* lns;
    __device__ __forceinline__ void operator()(f32x4 (&acc)[2][2][4][2], const Unit& u, int wr, int wc, int fr_, int fq_) const {
        int fr = fr_, fq = fq_; asm volatile("" : "+v"(fr), "+v"(fq));
        const int pn = u.pn; bf16_t* base; int ld, ct; bool act;
        if (pn < 4) { base = AU; ld = 1024; ct = pn; act = true; } else if (pn < 8) { base = AV; ld = 1024; ct = pn - 4; act = true; }
        else if (pn < 20) { base = FEAT; ld = 3072; ct = pn - 8; act = false; } else { base = LRAW; ld = 512; ct = pn - 20; act = false; }
        const int row0 = u.pm * BM + wr * 64 + fr, col0 = ct * BM + wc * 32 + 8 * fq;
#pragma unroll
        for (int ai = 0; ai < 2; ++ai)
#pragma unroll
            for (int m = 0; m < 4; ++m) { const int row = row0 + ai * HALF + m * 16; const float rs = rstd[row]; bf16_t* rowp = base + (size_t)row * ld + col0;
                float s1 = 0.f, s2 = 0.f;
#pragma unroll
                for (int bj = 0; bj < 2; ++bj) { f32x4 v0 = acc[ai][bj][m][0] * rs, v1 = acc[ai][bj][m][1] * rs;
                    if (act) { v0 = gelu4(v0); v1 = gelu4(v1); }
                    s1 += ((v0[0] + v0[1]) + (v0[2] + v0[3])) + ((v1[0] + v1[1]) + (v1[2] + v1[3]));
                    s2 += ((v0[0] * v0[0] + v0[1] * v0[1]) + (v0[2] * v0[2] + v0[3] * v0[3])) + ((v1[0] * v1[0] + v1[1] * v1[1]) + (v1[2] * v1[2] + v1[3] * v1[3]));
                    *(u32x4*)(rowp + bj * HALF) = pack8(v0, v1); }
                if (pn >= 4 && pn < 8) { s1 += __shfl_xor(s1, 16); s1 += __shfl_xor(s1, 32); s2 += __shfl_xor(s2, 16); s2 += __shfl_xor(s2, 32);
                    if (fq == 0) { lns[(size_t)row * 32 + (pn - 4) * 4 + wc] = s1; lns[(size_t)row * 32 + 16 + (pn - 4) * 4 + wc] = s2; } } }
    }
};
struct EpiGate {
    static constexpr bool PERM = true, AFTER_DRAIN = false;
    bf16_t* GAB; const float* rstd;
    __device__ __forceinline__ void operator()(f32x4 (&acc)[2][2][4][2], const Unit& u, int wr, int wc, int fr_, int fq_) const {
        int fr = fr_, fq = fq_; asm volatile("" : "+v"(fr), "+v"(fq));
        const int row0 = u.pm * BM + wr * 64 + fr, col0 = u.pn * BM + wc * 32 + 8 * fq;
#pragma unroll
        for (int ai = 0; ai < 2; ++ai)
#pragma unroll
            for (int m = 0; m < 4; ++m) { const int row = row0 + ai * HALF + m * 16; const float rs = rstd[row]; bf16_t* rowp = GAB + (size_t)row * 4096 + col0;
#pragma unroll
                for (int bj = 0; bj < 2; ++bj) { f32x4 v0 = acc[ai][bj][m][0] * rs, v1 = acc[ai][bj][m][1] * rs;
#pragma unroll
                    for (int i = 0; i < 4; ++i) { v0[i] = sigm(v0[i]); v1[i] = sigm(v1[i]); }
                    *(u32x4*)(rowp + bj * HALF) = pack8(v0, v1); } }
    }
};
struct EpiLora {
    static constexpr bool PERM = true, AFTER_DRAIN = false;
    float* DEC; bf16_t* AS; bf16_t* G; const float* w0; const float* a0;
    __device__ __forceinline__ void operator()(f32x4 (&acc)[2][2][4][2], const Unit& u, int wr, int wc, int fr_, int fq_) const {
        int fr = fr_, fq = fq_; asm volatile("" : "+v"(fr), "+v"(fq));
        const int pn = u.pn, kind = pn >> 2, ct = pn & 3;
        const int row0 = u.pm * BM + wr * 64 + fr, col0 = ct * BM + wc * 32 + 8 * fq;
        if (kind == 2) {
#pragma unroll
            for (int ai = 0; ai < 2; ++ai)
#pragma unroll
                for (int m = 0; m < 4; ++m) { bf16_t* rowp = G + (size_t)(row0 + ai * HALF + m * 16) * 1024 + col0;
#pragma unroll
                    for (int bj = 0; bj < 2; ++bj) *(u32x4*)(rowp + bj * HALF) = pack8(acc[ai][bj][m][0], acc[ai][bj][m][1]); }
        } else {
            const float* bias = kind == 0 ? w0 : a0;
#pragma unroll
            for (int bj = 0; bj < 2; ++bj) {
                const f32x4 b0 = *(const f32x4*)(bias + col0 + bj * HALF), b1 = *(const f32x4*)(bias + col0 + bj * HALF + 4);
#pragma unroll
                for (int ai = 0; ai < 2; ++ai)
#pragma unroll
                    for (int m = 0; m < 4; ++m) { const size_t off = (size_t)(row0 + ai * HALF + m * 16) * 1024 + col0 + bj * HALF;
                        f32x4 v0 = acc[ai][bj][m][0] + b0, v1 = acc[ai][bj][m][1] + b1;
                        if (kind == 0) {
#pragma unroll
                            for (int i = 0; i < 4; ++i) { float z = -v0[i]; float sp = fmaxf(z, 0.f) + __logf(1.0f + __expf(-fabsf(z))); v0[i] = __expf(-__expf(-sp - 0.5f));
                                                          z = -v1[i]; sp = fmaxf(z, 0.f) + __logf(1.0f + __expf(-fabsf(z))); v1[i] = __expf(-__expf(-sp - 0.5f)); }
                            *(f32x4*)(DEC + off) = v0; *(f32x4*)(DEC + off + 4) = v1;
                        } else {
#pragma unroll
                            for (int i = 0; i < 4; ++i) { v0[i] = sigm(v0[i]); v1[i] = sigm(v1[i]); }
                            *(u32x4*)(AS + off) = pack8(v0, v1);
                        }
                        }
            }
        }
    }
};
struct EpiPlain {
    static constexpr bool PERM = true, AFTER_DRAIN = false;
    bf16_t* O;
    __device__ __forceinline__ void operator()(f32x4 (&acc)[2][2][4][2], const Unit& u, int wr, int wc, int fr_, int fq_) const {
        int fr = fr_, fq = fq_; asm volatile("" : "+v"(fr), "+v"(fq));
        const int row0 = u.pm * BM + wr * 64 + fr, col0 = u.pn * BM + wc * 32 + 8 * fq;
#pragma unroll
        for (int ai = 0; ai < 2; ++ai)
#pragma unroll
            for (int m = 0; m < 4; ++m) { bf16_t* rowp = O + (size_t)(row0 + ai * HALF + m * 16) * 2048 + col0;
#pragma unroll
                for (int bj = 0; bj < 2; ++bj) *(u32x4*)(rowp + bj * HALF) = pack8(acc[ai][bj][m][0], acc[ai][bj][m][1]); }
    }
};
struct EpiMerge {
    static constexpr bool PERM = true, AFTER_DRAIN = false;
    const bf16_t* GAB; const bf16_t* PA; bf16_t* O;
    __device__ __forceinline__ void operator()(f32x4 (&acc)[2][2][4][2], const Unit& u, int wr, int wc, int fr_, int fq_) const {
        int fr = fr_, fq = fq_; asm volatile("" : "+v"(fr), "+v"(fq));
        const int row0 = u.pm * BM + wr * 64 + fr, col0 = u.pn * BM + wc * 32 + 8 * fq;
#pragma unroll
        for (int ai = 0; ai < 2; ++ai)
#pragma unroll
            for (int m = 0; m < 4; ++m) { const int row = row0 + ai * HALF + m * 16;
#pragma unroll
                for (int bj = 0; bj < 2; ++bj) { const int c = col0 + bj * HALF;
                    f32x4 ga0, ga1, gb0, gb1, p0, p1;
                    unpack8(*(const u32x4*)(GAB + (size_t)row * 4096 + c), ga0, ga1); unpack8(*(const u32x4*)(GAB + (size_t)row * 4096 + 2048 + c), gb0, gb1);
                    unpack8(*(const u32x4*)(PA + (size_t)row * 2048 + c), p0, p1);
                    const f32x4 o0 = ga0 * p0 + gb0 * acc[ai][bj][m][0], o1 = ga1 * p1 + gb1 * acc[ai][bj][m][1];
                    *(u32x4*)(O + (size_t)row * 2048 + c) = pack8(o0, o1); } }
    }
};
template <bool OUTF> struct EpiRes {
    static constexpr bool PERM = true, AFTER_DRAIN = false;
    const bf16_t* base; float* out; bf16_t* ob; float* ssq;
    __device__ __forceinline__ void operator()(f32x4 (&acc)[2][2][4][2], const Unit& u, int wr, int wc, int fr_, int fq_) const {
        int fr = fr_, fq = fq_; asm volatile("" : "+v"(fr), "+v"(fq));
        const int row0 = u.pm * BM + wr * 64 + fr, col0 = u.pn * BM + wc * 32 + 8 * fq;
#pragma unroll
        for (int ai = 0; ai < 2; ++ai)
#pragma unroll
            for (int m = 0; m < 4; ++m) { const int row = row0 + ai * HALF + m * 16; float s = 0.f;
#pragma unroll
                for (int bj = 0; bj < 2; ++bj) { const size_t off = (size_t)row * 2048 + col0 + bj * HALF;
                    f32x4 b0, b1; unpack8(*(const u32x4*)(base + off), b0, b1);
                    const f32x4 x0 = b0 + acc[ai][bj][m][0], x1 = b1 + acc[ai][bj][m][1];
                    if (OUTF) { *(f32x4*)(out + off) = x0; *(f32x4*)(out + off + 4) = x1; }
                    else *(u32x4*)(ob + off) = pack8(x0, x1);
                    s += (x0[0] * x0[0] + x0[1] * x0[1]) + (x0[2] * x0[2] + x0[3] * x0[3]) + (x1[0] * x1[0] + x1[1] * x1[1]) + (x1[2] * x1[2] + x1[3] * x1[3]); }
                s += __shfl_xor(s, 16); s += __shfl_xor(s, 32);
                if (fq == 0) ssq[(size_t)row * 32 + u.pn * 4 + wc] = s; }
    }
};
__device__ __forceinline__ float dpp_ror1(float x) { float r; asm volatile("s_nop 1\n\tv_mov_b32_dpp %0, %1 row_ror:1 row_mask:0xf bank_mask:0xf" : "=&v"(r) : "v"(x)); return r; }
__device__ __forceinline__ float dpp_ror2(float x) { float r; asm volatile("s_nop 1\n\tv_mov_b32_dpp %0, %1 row_ror:2 row_mask:0xf bank_mask:0xf" : "=&v"(r) : "v"(x)); return r; }
struct EpiUp {
    static constexpr bool PERM = true, AFTER_DRAIN = false;
    bf16_t* ACT; const float* ssq1; const float* cw; const float* cb; float* TOP; float* BOT; PG8_LAS unsigned char* el;
    __device__ __forceinline__ void operator()(f32x4 (&acc)[2][2][4][2], const Unit& u, int wr, int wc, int fr_, int fq_) const {
        int fr = fr_, fq = fq_; asm volatile("" : "+v"(fr), "+v"(fq));
        PG8_LAS float* rsL = (PG8_LAS float*)el; PG8_LAS float* hal = (PG8_LAS float*)(el + 1024);
        const int tid = threadIdx.x;
        if (tid < 256) { const f32x4* p = (const f32x4*)(ssq1 + (size_t)(u.pm * BM + tid) * 32); f32x4 s = p[0];
#pragma unroll
            for (int i = 1; i < 8; ++i) s += p[i];
            rsL[tid] = 1.0f / sqrtf(((s[0] + s[1]) + (s[2] + s[3])) * (1.0f / 2048.0f) + 1e-6f); }
        if (fr >= 14) {
#pragma unroll
            for (int ai = 0; ai < 2; ++ai)
#pragma unroll
                for (int bj = 0; bj < 2; ++bj)
#pragma unroll
                    for (int n = 0; n < 2; ++n) *(PG8_LAS f32x4*)(hal + ((2 * ai + wr) * 2 + (fr - 14)) * 256 + bj * HALF + wc * 32 + 8 * fq + 4 * n) = acc[ai][bj][3][n];
        }
        asm volatile("s_waitcnt lgkmcnt(0)" ::: "memory"); __builtin_amdgcn_s_barrier(); asm volatile("" ::: "memory");
        const int jcol = u.pn * HALF + wc * 32 + 8 * fq;
        if (wr == 1 && fr >= 14) { const float rsb = rsL[240 + fr];
#pragma unroll
            for (int bj = 0; bj < 2; ++bj)
#pragma unroll
                for (int n = 0; n < 2; ++n) *(f32x4*)(BOT + ((size_t)u.pm * 2 + (fr - 14)) * 11264 + u.pn * BM + bj * HALF + wc * 32 + 8 * fq + 4 * n) = acc[1][bj][3][n] * rsb; }
#pragma unroll
        for (int ai = 0; ai < 2; ++ai) {
            const int blk = 2 * ai + wr;
            float rsr[4];
#pragma unroll
            for (int m = 0; m < 4; ++m) rsr[m] = rsL[blk * 64 + m * 16 + fr];
            const float rs14 = blk ? rsL[blk * 64 - 2] : 0.f, rs15 = blk ? rsL[blk * 64 - 1] : 0.f;
#pragma unroll
            for (int bj = 0; bj < 2; ++bj)
#pragma unroll
                for (int n = 0; n < 2; ++n) {
                    const int ct = bj * HALF + wc * 32 + 8 * fq + 4 * n;
                    const int cidx = bj * 5632 + jcol + 4 * n;
                    const f32x4 w0 = *(const f32x4*)(cw + cidx), w1 = *(const f32x4*)(cw + 11264 + cidx), w2 = *(const f32x4*)(cw + 22528 + cidx), b4 = *(const f32x4*)(cb + cidx);
                    f32x4 pR1 = (f32x4){0.f, 0.f, 0.f, 0.f}, pR2 = pR1;
                    if (blk) { const f32x4 h14 = *(const PG8_LAS f32x4*)(hal + ((blk - 1) * 2 + 0) * 256 + ct) * rs14, h15 = *(const PG8_LAS f32x4*)(hal + ((blk - 1) * 2 + 1) * 256 + ct) * rs15;
                        pR1 = h15; pR2 = (fr == 0) ? h14 : h15; }
#pragma unroll
                    for (int m = 0; m < 4; ++m) {
                        const f32x4 U = acc[ai][bj][m][n] * rsr[m];
                        f32x4 R1, R2;
#pragma unroll
                        for (int i = 0; i < 4; ++i) { R1[i] = dpp_ror1(U[i]); R2[i] = dpp_ror2(U[i]); }
                        const f32x4 U1 = (fr >= 1) ? R1 : pR1, U2 = (fr >= 2) ? R2 : pR2;
                        const f32x4 C = b4 + w0 * U2 + w1 * U1 + w2 * U;
                        acc[ai][bj][m][n] = C; pR1 = R1; pR2 = R2;
                        asm volatile("" : "+v"(acc[ai][bj][m][n]));
                    }

                }
            if (ai == 0 && wr == 0 && fr < 2) {
#pragma unroll
                for (int bj = 0; bj < 2; ++bj)
#pragma unroll
                    for (int n = 0; n < 2; ++n) *(f32x4*)(TOP + ((size_t)u.pm * 2 + fr) * 11264 + u.pn * BM + bj * HALF + wc * 32 + 8 * fq + 4 * n) = acc[0][bj][0][n]; }
#pragma unroll
            for (int m = 0; m < 4; ++m) { const int row = u.pm * BM + blk * 64 + m * 16 + fr;
                const f32x4 g0 = gelu4(acc[ai][0][m][0]), g1 = gelu4(acc[ai][0][m][1]);
                *(u32x4*)(ACT + (size_t)row * 5632 + jcol) = pack8(g0 * acc[ai][1][m][0], g1 * acc[ai][1][m][1]); }
        }
    }
};
template <class Epi, class Sched, bool ALIGN_EPI = false, bool SP2 = false>
__device__ __forceinline__ void gemm_phase(PG8_LAS unsigned char* lds, const Gemm g, const Sched& S, const Epi& E) {
    const int tid = threadIdx.x, wid = __builtin_amdgcn_readfirstlane(tid >> 6), lane = tid & 63, wr = wid >> 2, wc = wid & 3, fr = lane & 15, fq = lane >> 4;
    const int K = g.K, nt = K / BK;
    unsigned voffA[2], voffB[2];
#pragma unroll
    for (int i = 0; i < 2; ++i) { int R, C; stage_rc(tid * 16 + i * 8192, R, C); const int Rb = Epi::PERM ? ((R & ~31) + perm32(R & 31)) : R;
        voffA[i] = (unsigned)(R * K + C) * 2u; voffB[i] = (unsigned)(Rb * K + C) * 2u; }
    const size_t kstep = (size_t)(BK * 2);
    const size_t hstep = (size_t)HALF * K * 2;
    const size_t tstep = 2 * hstep;
    const unsigned ldsw = (unsigned)wid * 1024u;
    const int aoff = lds_byte(wr * 64 + fr, fq * 8), boff = lds_byte(wc * 32 + fr, fq * 8);
#define PG8_SA(b, h) (((b) * 2 + (h)) * HTB)
#define PG8_SB(b, h) ((4 + (b) * 2 + (h)) * HTB)
#define PG8_STAGE(bufoff, gbase, voff) do { _Pragma("unroll") for (int _i = 0; _i < 2; ++_i) \
        __builtin_amdgcn_global_load_lds((const unsigned*)((const char*)(gbase) + (voff)[_i]), (PG8_LAS unsigned*)(lds + (bufoff) + ldsw + _i * 8192), 16, 0, 0); } while (0)
#define PG8_LDA(dst, b, h) do { _Pragma("unroll") for (int m = 0; m < 4; ++m) _Pragma("unroll") for (int k = 0; k < 2; ++k) dst[m][k] = *(const PG8_LAS bf16x8*)(lds + PG8_SA(b, h) + aoff + m * 2048 + k * 1024); } while (0)
#define PG8_LDB(dst, b, h) do { _Pragma("unroll") for (int n = 0; n < 2; ++n) _Pragma("unroll") for (int k = 0; k < 2; ++k) dst[n][k] = *(const PG8_LAS bf16x8*)(lds + PG8_SB(b, h) + boff + n * 2048 + k * 1024); } while (0)
#define PG8_MMA(ai, bj, At, Bt) do { __builtin_amdgcn_s_setprio(1); _Pragma("unroll") for (int m = 0; m < 4; ++m) _Pragma("unroll") for (int n = 0; n < 2; ++n) _Pragma("unroll") for (int k = 0; k < 2; ++k) \
        acc[ai][bj][m][n] = __builtin_amdgcn_mfma_f32_16x16x32_bf16(Bt[n][k], At[m][k], acc[ai][bj][m][n], 0, 0, 0); __builtin_amdgcn_s_setprio(0); } while (0)
#define PG8_WAIT_V(n) asm volatile("s_waitcnt vmcnt(" #n ")" ::: "memory")
#define PG8_WAIT_L(n) asm volatile("s_waitcnt lgkmcnt(" #n ")" ::: "memory")
#define PG8_BAR __builtin_amdgcn_s_barrier()
#define PG8_SCHED __builtin_amdgcn_sched_barrier(0)
    Unit cur, nxt; int ui = 0;
    if (!S.next(0, cur)) return;
    f32x4 acc[2][2][4][2];
#pragma unroll
    for (int a = 0; a < 2; ++a)
#pragma unroll
        for (int b = 0; b < 2; ++b)
#pragma unroll
            for (int m = 0; m < 4; ++m)
#pragma unroll
                for (int n = 0; n < 2; ++n) acc[a][b][m][n] = (f32x4){0.f, 0.f, 0.f, 0.f};
    bf16x8 At[4][2], B0[2][2], B1[2][2];
    const char* cA = (const char*)g.A + (size_t)cur.pm * tstep; const char* cB = (const char*)g.Bt + (size_t)cur.pn * tstep;
    S.a_ready(cur);
    if constexpr (SP2) {
        PG8_STAGE(PG8_SB(0, 0), cB, voffB); PG8_STAGE(PG8_SB(0, 1), cB + hstep, voffB); PG8_STAGE(PG8_SA(0, 0), cA, voffA); PG8_STAGE(PG8_SA(0, 1), cA + hstep, voffA);
        if (wr == 1) PG8_BAR;
        PG8_WAIT_V(2); PG8_BAR;
        PG8_STAGE(PG8_SB(1, 0), cB + kstep, voffB); PG8_STAGE(PG8_SA(1, 0), cA + kstep, voffA); PG8_STAGE(PG8_SB(1, 1), cB + hstep + kstep, voffB);
        PG8_WAIT_V(6); PG8_BAR;
    } else {
        PG8_STAGE(PG8_SB(0, 0), cB, voffB); PG8_STAGE(PG8_SA(0, 0), cA, voffA); PG8_STAGE(PG8_SB(0, 1), cB + hstep, voffB); PG8_STAGE(PG8_SA(0, 1), cA + hstep, voffA);
        if (wr == 1) PG8_BAR;
        PG8_WAIT_V(4); PG8_BAR;
        PG8_STAGE(PG8_SB(1, 0), cB + kstep, voffB); PG8_STAGE(PG8_SA(1, 0), cA + kstep, voffA); PG8_STAGE(PG8_SB(1, 1), cB + hstep + kstep, voffB);
        PG8_WAIT_V(6); PG8_BAR;
    }
    for (;;) {
        const bool has_next = S.next(ui + 1, nxt);
        const char* nA = has_next ? (const char*)g.A + (size_t)nxt.pm * tstep : cA; const char* nB = has_next ? (const char*)g.Bt + (size_t)nxt.pn * tstep : cB;
        for (int t = 0; t < nt; t += 2) {
            const bool last = (t == nt - 2);
            const char* a1 = cA + (size_t)(t + 1) * kstep;
            const char* a2 = last ? nA : cA + (size_t)(t + 2) * kstep; const char* b2 = last ? nB : cB + (size_t)(t + 2) * kstep;
            const char* a3 = a2 + kstep; const char* b3 = b2 + kstep;
            if (last && has_next) S.a_ready(nxt);
            if constexpr (SP2) {
            PG8_LDB(B0, 0, 0); PG8_LDB(B1, 0, 1); PG8_SCHED; PG8_LDA(At, 0, 0); PG8_STAGE(PG8_SA(1, 1), a1 + hstep, voffA);
            PG8_WAIT_V(8); PG8_WAIT_L(0); PG8_BAR; PG8_MMA(0, 0, At, B0); PG8_MMA(0, 1, At, B1); PG8_BAR; PG8_SCHED;
            PG8_LDA(At, 0, 1); PG8_STAGE(PG8_SB(0, 0), b2, voffB); PG8_STAGE(PG8_SB(0, 1), b2 + hstep, voffB); PG8_STAGE(PG8_SA(0, 0), a2, voffA);
            PG8_WAIT_V(8); PG8_WAIT_L(0); PG8_BAR; PG8_MMA(1, 0, At, B0); PG8_MMA(1, 1, At, B1); PG8_BAR; PG8_SCHED;
            PG8_LDB(B0, 1, 0); PG8_LDB(B1, 1, 1); PG8_SCHED; PG8_LDA(At, 1, 0); PG8_STAGE(PG8_SA(0, 1), a2 + hstep, voffA);
            PG8_WAIT_V(8); PG8_WAIT_L(0); PG8_BAR; PG8_MMA(0, 0, At, B0); PG8_MMA(0, 1, At, B1); PG8_BAR; PG8_SCHED;
            PG8_LDA(At, 1, 1); PG8_STAGE(PG8_SB(1, 0), b3, voffB); PG8_STAGE(PG8_SB(1, 1), b3 + hstep, voffB); PG8_STAGE(PG8_SA(1, 0), a3, voffA);
            PG8_WAIT_V(8); PG8_WAIT_L(0); PG8_BAR; PG8_MMA(1, 0, At, B0); PG8_MMA(1, 1, At, B1); PG8_BAR; PG8_SCHED;
            } else {
            PG8_LDB(B0, 0, 0); PG8_SCHED; PG8_LDA(At, 0, 0); PG8_STAGE(PG8_SA(1, 1), a1 + hstep, voffA);
            PG8_WAIT_L(8); PG8_BAR; PG8_WAIT_L(0); PG8_MMA(0, 0, At, B0); PG8_BAR; PG8_SCHED;
            PG8_LDB(B1, 0, 1); PG8_STAGE(PG8_SB(0, 0), b2, voffB);
            PG8_BAR; PG8_WAIT_L(0); PG8_MMA(0, 1, At, B1); PG8_BAR;
            PG8_LDA(At, 0, 1); PG8_STAGE(PG8_SA(0, 0), a2, voffA);
            PG8_BAR; PG8_WAIT_L(0); PG8_MMA(1, 0, At, B0); PG8_BAR; PG8_SCHED;
            PG8_STAGE(PG8_SB(0, 1), b2 + hstep, voffB);
            PG8_WAIT_V(6); PG8_BAR; PG8_MMA(1, 1, At, B1); PG8_BAR;
            PG8_LDB(B0, 1, 0); PG8_SCHED; PG8_LDA(At, 1, 0); PG8_STAGE(PG8_SA(0, 1), a2 + hstep, voffA);
            PG8_WAIT_L(8); PG8_BAR; PG8_WAIT_L(0); PG8_MMA(0, 0, At, B0); PG8_BAR; PG8_SCHED;
            PG8_LDB(B1, 1, 1); PG8_STAGE(PG8_SB(1, 0), b3, voffB);
            PG8_BAR; PG8_WAIT_L(0); PG8_MMA(0, 1, At, B1); PG8_BAR;
            PG8_LDA(At, 1, 1); PG8_STAGE(PG8_SA(1, 0), a3, voffA);
            PG8_BAR; PG8_WAIT_L(0); PG8_MMA(1, 0, At, B0); PG8_BAR; PG8_SCHED;
            PG8_STAGE(PG8_SB(1, 1), b3 + hstep, voffB);
            PG8_WAIT_V(6); PG8_BAR; PG8_MMA(1, 1, At, B1); PG8_BAR;
            }
        }
        if constexpr (ALIGN_EPI) { if (wr == 0) PG8_BAR; }
        if constexpr (!Epi::AFTER_DRAIN) { E(acc, cur, wr, wc, fr, fq); S.done(cur); }
        if (!has_next) break;
#pragma unroll
        for (int a = 0; a < 2; ++a)
#pragma unroll
            for (int b = 0; b < 2; ++b)
#pragma unroll
                for (int m = 0; m < 4; ++m)
#pragma unroll
                    for (int n = 0; n < 2; ++n) acc[a][b][m][n] = (f32x4){0.f, 0.f, 0.f, 0.f};
        cur = nxt; cA = nA; cB = nB; ++ui;
        if constexpr (ALIGN_EPI) { if (wr == 1) PG8_BAR; }
    }
    PG8_WAIT_V(0);
    if constexpr (!ALIGN_EPI) { if (wr == 0) PG8_BAR; }
    PG8_BAR;
    if constexpr (Epi::AFTER_DRAIN) { E.fused(acc, cur, wr, wc, fr, fq, lds, wid, lane); S.done(cur); }
#undef PG8_SA
#undef PG8_SB
#undef PG8_STAGE
#undef PG8_LDA
#undef PG8_LDB
#undef PG8_MMA
#undef PG8_WAIT_V
#undef PG8_WAIT_L
#undef PG8_BAR
#undef PG8_SCHED
}
}

#include <hip/hip_cooperative_groups.h>
namespace cg = cooperative_groups;
#define LAS __attribute__((address_space(3)))
typedef unsigned short bf16;
typedef float f32x4 __attribute__((ext_vector_type(4)));
typedef float f32x2 __attribute__((ext_vector_type(2)));
typedef short bf16x8 __attribute__((ext_vector_type(8)));
typedef unsigned u32x4 __attribute__((ext_vector_type(4)));
typedef unsigned u32x2 __attribute__((ext_vector_type(2)));

constexpr int T = 32768, SEQ = 16384, DM = 2048, DA = 1024, DB = 1024, NH = 16, DFF = 5632;
constexpr int N_IN1 = 5632, N_GATE = 4096, N_LORA = 3072, K_LORA = 384;
constexpr int NCH = 64, CL = SEQ / NCH;
constexpr int NWAVES = 8, NTHR = 512;
constexpr int LDS_BYTES = 147456, EPI_OFF = 131072 + 1024;
constexpr size_t MiB = 1u << 20;
constexpr size_t WS_W_IN = 0, WS_W_LORA = 38 * MiB, WS_W_PA = 41 * MiB, WS_W_PB = 45 * MiB, WS_W_OUT = 49 * MiB, WS_W_UP = 57 * MiB, WS_W_DOWN = 101 * MiB;
constexpr size_t WS_BAR = 135 * MiB, BAR_BYTES = 16384;
constexpr size_t WS_RSTD1 = 124 * MiB, WS_SSQ1 = 125 * MiB, WS_SSQ2 = 129 * MiB, WS_BONUS = 133 * MiB;
constexpr size_t WS_XB = 136 * MiB;
constexpr size_t WS_AU = 264 * MiB, WS_AV = 328 * MiB;
constexpr size_t WS_DEC = WS_AU, WS_MERGED = WS_AU;
constexpr size_t WS_FEAT = 392 * MiB;
constexpr size_t WS_PA = WS_FEAT, WS_ACT = WS_FEAT;
constexpr size_t WS_LRAW = 584 * MiB, WS_LIN = 616 * MiB;
constexpr size_t WS_AS = 640 * MiB, WS_ST = 896 * MiB;
constexpr size_t WS_G = 704 * MiB, WS_YA = 768 * MiB, WS_YB = 832 * MiB, WS_B = 896 * MiB;
constexpr size_t WS_TOP = 960 * MiB, WS_BOT = 971 * MiB, WS_END = 982 * MiB;

struct Params {
    const float* in[27]; float* out; unsigned char* ws; int ph_lo, ph_hi;
};
enum { I_X = 0, I_N1G, I_WIN, I_MU, I_W0, I_W2, I_A0, I_A2, I_G2, I_KK, I_KA, I_RK, I_LNW, I_LNB, I_GLNW, I_GLNB, I_GWS, I_GBS, I_WPA, I_WPB, I_WOUT, I_N2G, I_WUP, I_CW, I_CB, I_WDOWN, I_NFG };

__device__ __forceinline__ float bf2f(unsigned short h) { return __uint_as_float(((unsigned)h) << 16); }
__device__ __forceinline__ unsigned f2bf(float f) { unsigned u = __float_as_uint(f); return (u + 0x7fffu + ((u >> 16) & 1u)) >> 16; }
__device__ __forceinline__ unsigned pk2(float lo, float hi) { return pg8::cvt_pk_bf16(lo, hi); }
__device__ __forceinline__ float wave_sum(float v) {
#pragma unroll
    for (int o = 1; o < 64; o <<= 1) v += __shfl_xor(v, o);
    return v;
}
__device__ __forceinline__ float dpp_shr_z(float v, int ctrl_sel) {
    const int iv = __float_as_int(v); int r;
    switch (ctrl_sel) { case 1: r = __builtin_amdgcn_update_dpp(0, iv, 0x111, 0xf, 0xf, true); break; case 2: r = __builtin_amdgcn_update_dpp(0, iv, 0x112, 0xf, 0xf, true); break;
                        case 4: r = __builtin_amdgcn_update_dpp(0, iv, 0x114, 0xf, 0xf, true); break; default: r = __builtin_amdgcn_update_dpp(0, iv, 0x118, 0xf, 0xf, true); break; }
    return __int_as_float(r);
}
__device__ __forceinline__ void wave_sum2(float& a, float& b) {
    a += dpp_shr_z(a, 1); b += dpp_shr_z(b, 1); a += dpp_shr_z(a, 2); b += dpp_shr_z(b, 2); a += dpp_shr_z(a, 4); b += dpp_shr_z(b, 4); a += dpp_shr_z(a, 8); b += dpp_shr_z(b, 8);
    a += __int_as_float(__builtin_amdgcn_update_dpp(0, __float_as_int(a), 0x142, 0xa, 0xf, false)); b += __int_as_float(__builtin_amdgcn_update_dpp(0, __float_as_int(b), 0x142, 0xa, 0xf, false));
    a += __int_as_float(__builtin_amdgcn_update_dpp(0, __float_as_int(a), 0x143, 0xc, 0xf, false)); b += __int_as_float(__builtin_amdgcn_update_dpp(0, __float_as_int(b), 0x143, 0xc, 0xf, false));
    a = __int_as_float(__builtin_amdgcn_readlane(__float_as_int(a), 63)); b = __int_as_float(__builtin_amdgcn_readlane(__float_as_int(b), 63));
}
__device__ __forceinline__ float gelu_f(float x) { return 0.5f * x * (1.0f + erff(x * 0.70710678118654752f)); }
#define LDS_WAIT() asm volatile("s_waitcnt lgkmcnt(0)" ::: "memory")
#define RLF(v, k) __int_as_float(__builtin_amdgcn_readlane(__float_as_int(v), k))
#define DPPX(v, ctrl) __int_as_float(__builtin_amdgcn_update_dpp(0, __float_as_int(v), ctrl, 0xf, 0xf, false))
__device__ __forceinline__ float sum8(float v) { v += DPPX(v, 0xB1); v += DPPX(v, 0x4E); v += DPPX(v, 0x141); return v; }
__device__ __forceinline__ void ld8(const bf16* p, float (&o)[8]) { const u32x4 w = *(const u32x4*)p;
    o[0] = __uint_as_float(w.x << 16); o[1] = __uint_as_float(w.x & 0xffff0000u); o[2] = __uint_as_float(w.y << 16); o[3] = __uint_as_float(w.y & 0xffff0000u);
    o[4] = __uint_as_float(w.z << 16); o[5] = __uint_as_float(w.z & 0xffff0000u); o[6] = __uint_as_float(w.w << 16); o[7] = __uint_as_float(w.w & 0xffff0000u); }
__device__ __forceinline__ void st8(bf16* p, const float (&v)[8]) { u32x4 w; w.x = pk2(v[0], v[1]); w.y = pk2(v[2], v[3]); w.z = pk2(v[4], v[5]); w.w = pk2(v[6], v[7]); *(u32x4*)p = w; }
__device__ __forceinline__ void st8nt(bf16* p, const float (&v)[8]) { u32x4 w; w.x = pk2(v[0], v[1]); w.y = pk2(v[2], v[3]); w.z = pk2(v[4], v[5]); w.w = pk2(v[6], v[7]); __builtin_nontemporal_store(w, (u32x4*)p); }
__device__ __forceinline__ void ldf8(const float* p, float (&o)[8]) { const f32x4 a = *(const f32x4*)p, b = *(const f32x4*)(p + 4); o[0] = a[0]; o[1] = a[1]; o[2] = a[2]; o[3] = a[3]; o[4] = b[0]; o[5] = b[1]; o[6] = b[2]; o[7] = b[3]; }

__device__ __forceinline__ void tr_item(const float* W, int ldw, int srccol, int k0, const float* kscale, bf16* WT, int K, int drow0, LAS float* scr, int lane) {
    float v[64];
#pragma unroll
    for (int kk = 0; kk < 64; ++kk) v[kk] = (srccol >= 0) ? W[(size_t)(k0 + kk) * ldw + srccol] : 0.f;
    if (kscale) {
#pragma unroll
        for (int kk = 0; kk < 64; kk += 4) { const f32x4 s4 = *(const f32x4*)(kscale + k0 + kk); v[kk] *= s4[0]; v[kk + 1] *= s4[1]; v[kk + 2] *= s4[2]; v[kk + 3] *= s4[3]; } }
#pragma unroll
    for (int kk = 0; kk < 64; ++kk) scr[kk * 65 + lane] = v[kk];
    LDS_WAIT(); asm volatile("" ::: "memory");
    const int c = lane & 7;
#pragma unroll
    for (int j = 0; j < 8; ++j) { const int n = (lane >> 3) + 8 * j; const LAS float* s = scr + (8 * c) * 65 + n;
        u32x4 o; o.x = pk2(s[0 * 65], s[1 * 65]); o.y = pk2(s[2 * 65], s[3 * 65]); o.z = pk2(s[4 * 65], s[5 * 65]); o.w = pk2(s[6 * 65], s[7 * 65]);
        *(u32x4*)(WT + (size_t)(drow0 + n) * K + k0 + 8 * c) = o; }
    LDS_WAIT(); asm volatile("" ::: "memory");
}
template <int PART> __device__ __forceinline__ void convert_weights(const Params& p, LAS unsigned char* lds, int gw, int NGW) {
    const int lane = threadIdx.x & 63, wave = threadIdx.x >> 6;
    LAS float* scr = (LAS float*)(lds + wave * 16640);
    unsigned char* ws = p.ws;
    constexpr int I1 = 32 * 152, I2 = 16 * 32, I3 = 16 * 32, I4 = 32 * 32, I5 = 32 * 176, I6 = 88 * 32;
    if (PART == 0) {
        for (int r = gw; r < I1; r += NGW) { const int kb = r / 152, nb = r % 152, n0 = nb * 64, n = n0 + lane; const int src = n < 5408 ? n : (n < 5632 ? -1 : n - 224);
            tr_item(p.in[I_WIN], 9504, src, kb * 64, p.in[I_N1G], (bf16*)(ws + WS_W_IN), 2048, n0, scr, lane); }
    } else {
        for (int it = gw; it < I2 + I3 + I4 + I5 + I6; it += NGW) {
            int r = it;
            if (r < I2) { const int kb = r / 32, nb = r % 32; tr_item(p.in[I_WPA], 2048, nb * 64 + lane, kb * 64, nullptr, (bf16*)(ws + WS_W_PA), 1024, nb * 64, scr, lane); continue; } r -= I2;
            if (r < I3) { const int kb = r / 32, nb = r % 32; tr_item(p.in[I_WPB], 2048, nb * 64 + lane, kb * 64, nullptr, (bf16*)(ws + WS_W_PB), 1024, nb * 64, scr, lane); continue; } r -= I3;
            if (r < I4) { const int kb = r / 32, nb = r % 32; tr_item(p.in[I_WOUT], 2048, nb * 64 + lane, kb * 64, nullptr, (bf16*)(ws + WS_W_OUT), 2048, nb * 64, scr, lane); continue; } r -= I4;
            if (r < I5) { const int kb = r / 176, nb = r % 176, n0 = nb * 64, n = n0 + lane, j = n >> 8, w = n & 255; const int src = w < 128 ? 128 * j + w : 5632 + 128 * j + (w - 128);
                tr_item(p.in[I_WUP], 11264, src, kb * 64, p.in[I_N2G], (bf16*)(ws + WS_W_UP), 2048, n0, scr, lane); continue; } r -= I5;
            { const int kb = r / 32, nb = r % 32; tr_item(p.in[I_WDOWN], 2048, nb * 64 + lane, kb * 64, nullptr, (bf16*)(ws + WS_W_DOWN), 5632, nb * 64, scr, lane); }
        }
    }
}
__device__ __forceinline__ void phase_prologue(const Params& p, LAS unsigned char* lds) {
    const int tid = threadIdx.x, lane = tid & 63, wave = tid >> 6, G = gridDim.x;
    const int gw = blockIdx.x * NWAVES + wave, NGW = G * NWAVES;
    unsigned char* ws = p.ws;
    convert_weights<0>(p, lds, gw, NGW);
    if (G <= 128) convert_weights<1>(p, lds, gw, NGW);
    { bf16* WL = (bf16*)(ws + WS_W_LORA); const int gt = blockIdx.x * NTHR + tid, NGT = G * NTHR;
      for (int i = gt; i < N_LORA * K_LORA; i += NGT) { const int n = i / K_LORA, k = i % K_LORA; float v = 0.f;
          if (n < 1024) { if (k < 64) v = p.in[I_W2][k * 1024 + n]; }
          else if (n < 2048) { if (k >= 64 && k < 128) v = p.in[I_A2][(k - 64) * 1024 + (n - 1024)]; }
          else { if (k >= 128 && k < 288) v = p.in[I_G2][(k - 128) * 1024 + (n - 2048)]; }
          WL[i] = (bf16)f2bf(v); } }
    { const float* x = p.in[I_X]; bf16* xb = (bf16*)(ws + WS_XB); float* rstd = (float*)(ws + WS_RSTD1);
      constexpr int UR = 4;
      for (int row0 = gw; row0 < T; row0 += UR * NGW) { f32x4 v[UR][8]; float s[UR];
#pragma unroll
          for (int u = 0; u < UR; ++u) { const f32x4* xr = (const f32x4*)(x + (size_t)(row0 + u * NGW) * DM) + lane;
#pragma unroll
              for (int j = 0; j < 8; ++j) v[u][j] = __builtin_nontemporal_load(xr + 64 * j); }
#pragma unroll
          for (int u = 0; u < UR; ++u) { const int row = row0 + u * NGW; s[u] = 0.f;
#pragma unroll
              for (int j = 0; j < 8; ++j) s[u] += (v[u][j][0] * v[u][j][0] + v[u][j][1] * v[u][j][1]) + (v[u][j][2] * v[u][j][2] + v[u][j][3] * v[u][j][3]);
              s[u] = wave_sum(s[u]); if (lane == 0) rstd[row] = 1.0f / sqrtf(s[u] * (1.0f / DM) + 1e-6f);
              u32x2* o = (u32x2*)(xb + (size_t)row * DM) + lane;
#pragma unroll
              for (int j = 0; j < 8; ++j) { u32x2 w; w.x = pk2(v[u][j][0], v[u][j][1]); w.y = pk2(v[u][j][2], v[u][j][3]); o[64 * j] = w; } } } }
}

__device__ __forceinline__ void phase_gmlp(const Params& p, LAS unsigned char* lds) {
    const int tid = threadIdx.x, lane = tid & 63, wave = tid >> 6, G = gridDim.x;
    unsigned char* ws = p.ws;
    const bf16* AU = (const bf16*)(ws + WS_AU); const bf16* AV = (const bf16*)(ws + WS_AV); bf16* YA = (bf16*)(ws + WS_YA);
    const float* LNS = (const float*)(ws + WS_SSQ2);
    LAS bf16* WM = (LAS bf16*)lds;
    LAS bf16* VT = (LAS bf16*)(lds + 34816);
    LAS float* st = (LAS float*)(lds + 69632);
    const int g = blockIdx.x & 7, nb = G >> 3;
    if ((int)blockIdx.x < nb * 8) {
        __syncthreads();
        { const float* wg = p.in[I_GWS] + (size_t)g * 16384;
#pragma unroll
          for (int j = 0; j < 8; ++j) { const int e = tid + 512 * j, t = e >> 5, s4 = (e & 31) * 4; f32x4 w = *(const f32x4*)(wg + t * 128 + s4);
#pragma unroll
              for (int i = 0; i < 4; ++i) if (s4 + i > t) w[i] = 0.f;
              u32x2 o; o.x = pk2(w[0], w[1]); o.y = pk2(w[2], w[3]); *(LAS u32x2*)(WM + t * 136 + s4) = o; } }
        const int c8 = (tid & 15) * 8;
        float lw8[8], lb8[8]; ldf8(p.in[I_GLNW] + g * 128 + c8, lw8); ldf8(p.in[I_GLNB] + g * 128 + c8, lb8);
        const float* bsg = p.in[I_GBS] + g * 128;
        u32x4 avn[4];
        { const int ch0 = blockIdx.x >> 3;
#pragma unroll
          for (int i = 0; i < 4; ++i) { const int s = (tid >> 4) + 32 * i; avn[i] = (ch0 < T / 128) ? *(const u32x4*)(AV + (size_t)(ch0 * 128 + s) * DA + g * 128 + c8) : (u32x4){0u, 0u, 0u, 0u}; } }
        for (int ch = blockIdx.x >> 3; ch < T / 128; ch += nb) {
            const int t0 = ch * 128;
            float av[4][8];
#pragma unroll
            for (int i = 0; i < 4; ++i) { f32x4 x0, x1; pg8::unpack8(avn[i], x0, x1); av[i][0] = x0[0]; av[i][1] = x0[1]; av[i][2] = x0[2]; av[i][3] = x0[3]; av[i][4] = x1[0]; av[i][5] = x1[1]; av[i][6] = x1[2]; av[i][7] = x1[3]; }
            if (tid < 128) { const f32x4* q = (const f32x4*)(LNS + (size_t)(t0 + tid) * 32); f32x4 a = q[0] + q[1] + q[2] + q[3], b = q[4] + q[5] + q[6] + q[7];
                const float mean = ((a[0] + a[1]) + (a[2] + a[3])) * (1.0f / DA), ex2 = ((b[0] + b[1]) + (b[2] + b[3])) * (1.0f / DA);
                st[tid] = mean; st[128 + tid] = 1.0f / sqrtf(fmaxf(ex2 - mean * mean, 0.f) + 1e-5f); }
            __syncthreads();
#pragma unroll
            for (int i = 0; i < 4; ++i) { const int s = (tid >> 4) + 32 * i; const float mean = st[s], rs = st[128 + s];
#pragma unroll
                for (int j = 0; j < 8; ++j) VT[(c8 + j) * 136 + ((((s >> 3) ^ (tid & 15)) << 3) | (s & 7))] = (bf16)f2bf((av[i][j] - mean) * rs * lw8[j] + lb8[j]); }
            __syncthreads();
            if (ch + nb < T / 128) {
#pragma unroll
                for (int i = 0; i < 4; ++i) { const int s = (tid >> 4) + 32 * i; avn[i] = *(const u32x4*)(AV + (size_t)((ch + nb) * 128 + s) * DA + g * 128 + c8); } }
            const size_t rowo = (size_t)(t0 + 16 * wave + (lane & 15)) * DA + g * 128 + 4 * (lane >> 4);
            u32x2 aur[8];
#pragma unroll
            for (int ct = 0; ct < 8; ++ct) aur[ct] = *(const u32x2*)(AU + rowo + 16 * ct);
            f32x4 acc[8];
#pragma unroll
            for (int ct = 0; ct < 8; ++ct) acc[ct] = (f32x4){0.f, 0.f, 0.f, 0.f};
            const int nk = (16 * wave + 15) / 32 + 1;
            for (int ks = 0; ks < nk; ++ks) { const bf16x8 wmf = *(const LAS bf16x8*)(WM + (16 * wave + (lane & 15)) * 136 + ks * 32 + 8 * (lane >> 4));
#pragma unroll
                for (int ct = 0; ct < 8; ++ct) { const bf16x8 vtf = *(const LAS bf16x8*)(VT + (16 * ct + (lane & 15)) * 136 + (((ks * 4 + (lane >> 4)) ^ (2 * ct + ((lane & 15) >> 3))) << 3));
                    acc[ct] = __builtin_amdgcn_mfma_f32_16x16x32_bf16(vtf, wmf, acc[ct], 0, 0, 0); } }
            { const float bsv = bsg[16 * wave + (lane & 15)];
#pragma unroll
              for (int ct = 0; ct < 8; ++ct) { const u32x2 aw = aur[ct];
                  const float o0 = (acc[ct][0] + bsv) * __uint_as_float(aw.x << 16), o1 = (acc[ct][1] + bsv) * __uint_as_float(aw.x & 0xffff0000u);
                  const float o2 = (acc[ct][2] + bsv) * __uint_as_float(aw.y << 16), o3 = (acc[ct][3] + bsv) * __uint_as_float(aw.y & 0xffff0000u);
                  u32x2 w; w.x = pk2(o0, o1); w.y = pk2(o2, o3); *(u32x2*)(YA + rowo + 16 * ct) = w; } }
        }
    }
    { const bf16* LRAW = (const bf16*)(ws + WS_LRAW); bf16* LIN = (bf16*)(ws + WS_LIN); const float* mu = p.in[I_MU];
      const int gt = blockIdx.x * NTHR + tid, NGT = G * NTHR;
      for (int i0 = gt; i0 < T * 48; i0 += 4 * NGT) { float cur[4][8], prev[4][8];
#pragma unroll
          for (int u = 0; u < 4; ++u) { const int i = i0 + u * NGT; if (i < T * 48) { const int t = i / 48, c = (i % 48) * 8;
              if (c < 288) { ld8(LRAW + (size_t)t * 512 + c, cur[u]); ld8(LRAW + (size_t)((t % SEQ) ? t - 1 : t) * 512 + c, prev[u]); } } }
#pragma unroll
          for (int u = 0; u < 4; ++u) { const int i = i0 + u * NGT; if (i < T * 48) { const int t = i / 48, c = (i % 48) * 8; float o[8];
              if (c < 288) { float m8[8]; ldf8(mu + 3072 + c, m8); const bool first = (t % SEQ) == 0;
#pragma unroll
                  for (int j = 0; j < 8; ++j) { const float pv = first ? 0.f : prev[u][j]; const float m = cur[u][j] + (pv - cur[u][j]) * m8[j];
                      o[j] = c < 64 ? tanhf(m) : (c < 128 ? m : 1.0f / (1.0f + __expf(-m))); } }
              else {
#pragma unroll
                  for (int j = 0; j < 8; ++j) o[j] = 0.f; }
              st8(LIN + (size_t)t * K_LORA + c, o); } } } }
}

#define SCAN_FENCE(j)
template <bool PASS2> struct ScanCfg { static constexpr int SB = 4; };
template <bool PASS2, int MODE = 0> __device__ __forceinline__ void phase_scan(const Params& p, LAS unsigned char* lds) {
    constexpr int SB = ScanCfg<PASS2>::SB; constexpr int NV = PASS2 ? 8 : 6;
    const int tid = threadIdx.x, lane = tid & 63, wave = tid >> 6, G = gridDim.x;
    const int gw = blockIdx.x * NWAVES + wave, NGW = G * NWAVES;
    unsigned char* ws = p.ws;
    const float* DEC = (const float*)(ws + WS_DEC);
    const bf16* R = (const bf16*)p.out; const bf16* KF = R + (size_t)T * DB; const bf16* V = KF + (size_t)T * DB; const bf16* KKN = V + (size_t)T * DB; const bf16* Bv = (const bf16*)(ws + WS_B);
    const bf16* Gt = (const bf16*)(ws + WS_G); const float* BON = (const float*)(ws + WS_BONUS); bf16* YB = (bf16*)(ws + WS_YB);
    float* ST = (float*)(ws + WS_ST); float* YT = (float*)p.out; bf16* ZT = (bf16*)p.out + (size_t)3 * T * DB;
    const bf16* FEAT = (const bf16*)(ws + WS_FEAT); const bf16* AS = (const bf16*)(ws + WS_AS); bf16* Vw = (bf16*)p.out + (size_t)2 * T * DB; float* BONw = (float*)(ws + WS_BONUS);
    LAS float* buf = (LAS float*)(lds + wave * 16384);
    for (int u = gw; u < 32 * NCH; u += NGW) {
        const int bh = u / NCH, ch = u % NCH, b = bh >> 4, h = bh & 15; int lnl = lane; asm volatile("" : "+v"(lnl));
        const unsigned i0 = (unsigned)((b * SEQ + ch * CL) * DB + h * 64) + (unsigned)lnl;
        const unsigned q0 = (unsigned)((b * SEQ + ch * CL) * NH + h);
        const unsigned f0 = (unsigned)((b * SEQ + ch * CL) * 3072 + h * 64) + (unsigned)lnl;
        const int cc_ = h * 64 + lnl;
        const float mur = p.in[I_MU][cc_], muk = p.in[I_MU][1024 + cc_], muv = p.in[I_MU][2048 + cc_], ckk = p.in[I_KK][cc_], cka = p.in[I_KA][cc_], crk = p.in[I_RK][cc_];
        float pr = 0.f, pk = 0.f, pv = 0.f;
        if (ch > 0) { pr = bf2f(FEAT[f0 - 3072u]); pk = bf2f(FEAT[f0 - 3072u + 1024]); pv = bf2f(FEAT[f0 - 3072u + 2048]); }
        f32x2 Q2[32], P2[32];
#pragma unroll
        for (int k = 0; k < 32; ++k) { Q2[k] = (f32x2){0.f, 0.f}; P2[k] = (f32x2){(2 * k == lnl) ? 1.f : 0.f, (2 * k + 1 == lnl) ? 1.f : 0.f}; }
        float lw = 0.f, lb = 0.f;
        if (PASS2) { lw = p.in[I_LNW][h * 64 + lane]; lb = p.in[I_LNB][h * 64 + lane];
            if (ch > 0) { const f32x4* s = (const f32x4*)(ST + ((size_t)(u - 1) * 2) * 4096 + lane * 64);
#pragma unroll
                for (int j = 0; j < 16; ++j) { const f32x4 x = s[j]; Q2[2 * j] = x.xy; Q2[2 * j + 1] = x.zw; } } }
        float rg[SB][NV];
#define SCAN_LOAD(seg) do { _Pragma("unroll") for (int s = 0; s < SB; ++s) { const unsigned st_ = (unsigned)((seg) * SB + s); const unsigned ix = i0 + st_ * DB, fx = f0 + st_ * 3072u; \
            rg[s][0] = DEC[ix]; rg[s][1] = bf2f(FEAT[fx]); rg[s][2] = bf2f(FEAT[fx + 1024]); rg[s][3] = bf2f(FEAT[fx + 2048]); rg[s][4] = bf2f(AS[ix]); } } while (0)
#define SCAN_STORE(bi, seg) do { _Pragma("unroll") for (int s = 0; s < SB; ++s) { const unsigned st_ = (unsigned)((seg) * SB + s); \
            const float cr_ = rg[s][1], ck_ = rg[s][2], cv_ = rg[s][3], a_ = rg[s][4]; \
            const float r_ = cr_ + (pr - cr_) * mur, k_ = ck_ + (pk - ck_) * muk, v_ = cv_ + (pv - cv_) * muv; pr = cr_; pk = ck_; pv = cv_; \
            const float kk_ = k_ * ckk, kf_ = k_ * (1.0f + (a_ - 1.0f) * cka); float n2_ = kk_ * kk_, bon_ = r_ * kf_ * crk; wave_sum2(n2_, bon_); \
            const float kkn_ = kk_ * __builtin_amdgcn_rsqf(fmaxf(n2_, 1e-24f)); \
            LAS float* d_ = buf + (((bi) * SB + s) * NV) * 64 + lane; d_[0] = rg[s][0]; d_[64] = kkn_; d_[128] = kkn_ * a_; d_[192] = kf_; d_[256] = v_; d_[320] = r_; \
            if (MODE == 0) { Vw[i0 + st_ * DB] = (bf16)f2bf(v_); if (lane == 0) BONw[q0 + st_ * NH] = bon_; } } } while (0)
        SCAN_LOAD(0); SCAN_STORE(0, 0);
        for (int seg = 0; seg < CL / SB; ++seg) {
            const int bi = seg & 1;
            if (MODE != 2 && seg + 1 < CL / SB) SCAN_LOAD(seg + 1);
            asm volatile("" ::: "memory");
#define RLF_UNUSED 0
#define DPPFMAC(acc, rep, val, n) asm("v_fmac_f32_dpp %0, %1, %2 row_newbcast:" #n " row_mask:0xf bank_mask:0xf" : "+v"(acc) : "v"(rep), "v"(val))
#pragma unroll 1
            for (int s = 0; s < (MODE == 1 ? 0 : SB); ++s) {
                const LAS float* sv = buf + ((bi * SB + s) * NV) * 64;
                const LAS f32x4* L4 = (const LAS f32x4*)sv;
                f32x2 qloa = {0.f, 0.f}, qhia = qloa, qlob = qloa, qhib = qloa, plo = qloa, phi = qloa, yloa = qloa, yhia = qloa, ylob = qloa, yhib = qloa, saq2 = qloa, sap2 = qloa;
                const float vv = sv[4 * 64 + lane]; const f32x2 vv2 = {vv, vv};
                const float xk = sv[1 * 64 + lane], xb = sv[2 * 64 + lane], xr = sv[5 * 64 + lane];
                float qd0 = 0.f, qd1 = 0.f, qd2 = 0.f, qd3 = 0.f, pd0 = 0.f, pd1 = 0.f, pd2 = 0.f, pd3 = 0.f, yd0 = 0.f, yd1 = 0.f, yd2 = 0.f, yd3 = 0.f, zd0 = 0.f, zd1 = 0.f, zd2 = 0.f, zd3 = 0.f;
                const int l15 = lane & 15; float xkq0 = sv[64 + l15], xkq1 = sv[64 + 16 + l15], xkq2 = sv[64 + 32 + l15], xkq3 = sv[64 + 48 + l15], xrq0 = sv[320 + l15], xrq1 = sv[320 + 16 + l15], xrq2 = sv[320 + 32 + l15], xrq3 = sv[320 + 48 + l15];
                asm volatile("s_nop 1" : "+v"(xkq0), "+v"(xkq1), "+v"(xkq2), "+v"(xkq3));
                if constexpr (PASS2) {
                __builtin_amdgcn_sched_barrier(0);
                { const f32x2 kxy = (f32x2){RLF(xk, 0), RLF(xk, 1)}, kzw = (f32x2){RLF(xk, 2), RLF(xk, 3)};
                qloa += Q2[0] * kxy; qhia += Q2[1] * kzw; }
                { const f32x2 kxy = (f32x2){RLF(xk, 4), RLF(xk, 5)}, kzw = (f32x2){RLF(xk, 6), RLF(xk, 7)};
                qlob += Q2[2] * kxy; qhib += Q2[3] * kzw; }
                { const f32x2 kxy = (f32x2){RLF(xk, 8), RLF(xk, 9)}, kzw = (f32x2){RLF(xk, 10), RLF(xk, 11)};
                qloa += Q2[4] * kxy; qhia += Q2[5] * kzw; }
                { const f32x2 kxy = (f32x2){RLF(xk, 12), RLF(xk, 13)}, kzw = (f32x2){RLF(xk, 14), RLF(xk, 15)};
                qlob += Q2[6] * kxy; qhib += Q2[7] * kzw; }
                __builtin_amdgcn_sched_barrier(0);
                { const f32x2 kxy = (f32x2){RLF(xk, 16), RLF(xk, 17)}, kzw = (f32x2){RLF(xk, 18), RLF(xk, 19)};
                qloa += Q2[8] * kxy; qhia += Q2[9] * kzw; }
                { const f32x2 kxy = (f32x2){RLF(xk, 20), RLF(xk, 21)}, kzw = (f32x2){RLF(xk, 22), RLF(xk, 23)};
                qlob += Q2[10] * kxy; qhib += Q2[11] * kzw; }
                { const f32x2 kxy = (f32x2){RLF(xk, 24), RLF(xk, 25)}, kzw = (f32x2){RLF(xk, 26), RLF(xk, 27)};
                qloa += Q2[12] * kxy; qhia += Q2[13] * kzw; }
                { const f32x2 kxy = (f32x2){RLF(xk, 28), RLF(xk, 29)}, kzw = (f32x2){RLF(xk, 30), RLF(xk, 31)};
                qlob += Q2[14] * kxy; qhib += Q2[15] * kzw; }
                __builtin_amdgcn_sched_barrier(0);
                f32x4 d_0 = L4[0], k_0 = L4[48];
                f32x4 r_0 = L4[80];
                f32x4 d_1 = L4[1], k_1 = L4[49];
                f32x4 r_1 = L4[81];
                { const f32x2 kxy = (f32x2){RLF(xk, 32), RLF(xk, 33)}, kzw = (f32x2){RLF(xk, 34), RLF(xk, 35)};
                qloa += Q2[16] * kxy; qhia += Q2[17] * kzw; }
                { const f32x2 kxy = (f32x2){RLF(xk, 36), RLF(xk, 37)}, kzw = (f32x2){RLF(xk, 38), RLF(xk, 39)};
                qlob += Q2[18] * kxy; qhib += Q2[19] * kzw; }
                { const f32x2 kxy = (f32x2){RLF(xk, 40), RLF(xk, 41)}, kzw = (f32x2){RLF(xk, 42), RLF(xk, 43)};
                qloa += Q2[20] * kxy; qhia += Q2[21] * kzw; }
                { const f32x2 kxy = (f32x2){RLF(xk, 44), RLF(xk, 45)}, kzw = (f32x2){RLF(xk, 46), RLF(xk, 47)};
                qlob += Q2[22] * kxy; qhib += Q2[23] * kzw; }
                __builtin_amdgcn_sched_barrier(0);
                f32x4 d_2 = L4[2], k_2 = L4[50];
                f32x4 r_2 = L4[82];
                f32x4 d_3 = L4[3], k_3 = L4[51];
                f32x4 r_3 = L4[83];
                { const f32x2 kxy = (f32x2){RLF(xk, 48), RLF(xk, 49)}, kzw = (f32x2){RLF(xk, 50), RLF(xk, 51)};
                qloa += Q2[24] * kxy; qhia += Q2[25] * kzw; }
                { const f32x2 kxy = (f32x2){RLF(xk, 52), RLF(xk, 53)}, kzw = (f32x2){RLF(xk, 54), RLF(xk, 55)};
                qlob += Q2[26] * kxy; qhib += Q2[27] * kzw; }
                { const f32x2 kxy = (f32x2){RLF(xk, 56), RLF(xk, 57)}, kzw = (f32x2){RLF(xk, 58), RLF(xk, 59)};
                qloa += Q2[28] * kxy; qhia += Q2[29] * kzw; }
                { const f32x2 kxy = (f32x2){RLF(xk, 60), RLF(xk, 61)}, kzw = (f32x2){RLF(xk, 62), RLF(xk, 63)};
                qlob += Q2[30] * kxy; qhib += Q2[31] * kzw; }
                { const f32x2 qs = (qloa + qlob) + (qhia + qhib), ps = plo + phi; const float saq = -(qs.x + qs.y), sap = -(ps.x + ps.y); saq2 = (f32x2){saq, saq}; sap2 = (f32x2){sap, sap}; }
                __builtin_amdgcn_sched_barrier(0);
                f32x4 d_4 = L4[4], k_4 = L4[52];
                f32x4 r_4 = L4[84];
                f32x4 d_5 = L4[5], k_5 = L4[53];
                f32x4 r_5 = L4[85];
                { const f32x2 bxy = (f32x2){RLF(xb, 0), RLF(xb, 1)}, bzw = (f32x2){RLF(xb, 2), RLF(xb, 3)};
                Q2[0] = Q2[0] * d_0.xy + (saq2 * bxy + vv2 * k_0.xy); Q2[1] = Q2[1] * d_0.zw + (saq2 * bzw + vv2 * k_0.zw);
                yloa += Q2[0] * r_0.xy; yhia += Q2[1] * r_0.zw; }
                { const f32x2 bxy = (f32x2){RLF(xb, 4), RLF(xb, 5)}, bzw = (f32x2){RLF(xb, 6), RLF(xb, 7)};
                Q2[2] = Q2[2] * d_1.xy + (saq2 * bxy + vv2 * k_1.xy); Q2[3] = Q2[3] * d_1.zw + (saq2 * bzw + vv2 * k_1.zw);
                ylob += Q2[2] * r_1.xy; yhib += Q2[3] * r_1.zw; }
                __builtin_amdgcn_sched_barrier(0);
                f32x4 d_6 = L4[6], k_6 = L4[54];
                f32x4 r_6 = L4[86];
                f32x4 d_7 = L4[7], k_7 = L4[55];
                f32x4 r_7 = L4[87];
                { const f32x2 bxy = (f32x2){RLF(xb, 8), RLF(xb, 9)}, bzw = (f32x2){RLF(xb, 10), RLF(xb, 11)};
                Q2[4] = Q2[4] * d_2.xy + (saq2 * bxy + vv2 * k_2.xy); Q2[5] = Q2[5] * d_2.zw + (saq2 * bzw + vv2 * k_2.zw);
                yloa += Q2[4] * r_2.xy; yhia += Q2[5] * r_2.zw; }
                { const f32x2 bxy = (f32x2){RLF(xb, 12), RLF(xb, 13)}, bzw = (f32x2){RLF(xb, 14), RLF(xb, 15)};
                Q2[6] = Q2[6] * d_3.xy + (saq2 * bxy + vv2 * k_3.xy); Q2[7] = Q2[7] * d_3.zw + (saq2 * bzw + vv2 * k_3.zw);
                ylob += Q2[6] * r_3.xy; yhib += Q2[7] * r_3.zw; }
                __builtin_amdgcn_sched_barrier(0);
                f32x4 d_8 = L4[8], k_8 = L4[56];
                f32x4 r_8 = L4[88];
                f32x4 d_9 = L4[9], k_9 = L4[57];
                f32x4 r_9 = L4[89];
                { const f32x2 bxy = (f32x2){RLF(xb, 16), RLF(xb, 17)}, bzw = (f32x2){RLF(xb, 18), RLF(xb, 19)};
                Q2[8] = Q2[8] * d_4.xy + (saq2 * bxy + vv2 * k_4.xy); Q2[9] = Q2[9] * d_4.zw + (saq2 * bzw + vv2 * k_4.zw);
                yloa += Q2[8] * r_4.xy; yhia += Q2[9] * r_4.zw; }
                { const f32x2 bxy = (f32x2){RLF(xb, 20), RLF(xb, 21)}, bzw = (f32x2){RLF(xb, 22), RLF(xb, 23)};
                Q2[10] = Q2[10] * d_5.xy + (saq2 * bxy + vv2 * k_5.xy); Q2[11] = Q2[11] * d_5.zw + (saq2 * bzw + vv2 * k_5.zw);
                ylob += Q2[10] * r_5.xy; yhib += Q2[11] * r_5.zw; }
                __builtin_amdgcn_sched_barrier(0);
                f32x4 d_10 = L4[10], k_10 = L4[58];
                f32x4 r_10 = L4[90];
                f32x4 d_11 = L4[11], k_11 = L4[59];
                f32x4 r_11 = L4[91];
                { const f32x2 bxy = (f32x2){RLF(xb, 24), RLF(xb, 25)}, bzw = (f32x2){RLF(xb, 26), RLF(xb, 27)};
                Q2[12] = Q2[12] * d_6.xy + (saq2 * bxy + vv2 * k_6.xy); Q2[13] = Q2[13] * d_6.zw + (saq2 * bzw + vv2 * k_6.zw);
                yloa += Q2[12] * r_6.xy; yhia += Q2[13] * r_6.zw; }
                { const f32x2 bxy = (f32x2){RLF(xb, 28), RLF(xb, 29)}, bzw = (f32x2){RLF(xb, 30), RLF(xb, 31)};
                Q2[14] = Q2[14] * d_7.xy + (saq2 * bxy + vv2 * k_7.xy); Q2[15] = Q2[15] * d_7.zw + (saq2 * bzw + vv2 * k_7.zw);
                ylob += Q2[14] * r_7.xy; yhib += Q2[15] * r_7.zw; }
                __builtin_amdgcn_sched_barrier(0);
                f32x4 d_12 = L4[12], k_12 = L4[60];
                f32x4 r_12 = L4[92];
                f32x4 d_13 = L4[13], k_13 = L4[61];
                f32x4 r_13 = L4[93];
                { const f32x2 bxy = (f32x2){RLF(xb, 32), RLF(xb, 33)}, bzw = (f32x2){RLF(xb, 34), RLF(xb, 35)};
                Q2[16] = Q2[16] * d_8.xy + (saq2 * bxy + vv2 * k_8.xy); Q2[17] = Q2[17] * d_8.zw + (saq2 * bzw + vv2 * k_8.zw);
                yloa += Q2[16] * r_8.xy; yhia += Q2[17] * r_8.zw; }
                { const f32x2 bxy = (f32x2){RLF(xb, 36), RLF(xb, 37)}, bzw = (f32x2){RLF(xb, 38), RLF(xb, 39)};
                Q2[18] = Q2[18] * d_9.xy + (saq2 * bxy + vv2 * k_9.xy); Q2[19] = Q2[19] * d_9.zw + (saq2 * bzw + vv2 * k_9.zw);
                ylob += Q2[18] * r_9.xy; yhib += Q2[19] * r_9.zw; }
                __builtin_amdgcn_sched_barrier(0);
                f32x4 d_14 = L4[14], k_14 = L4[62];
                f32x4 r_14 = L4[94];
                f32x4 d_15 = L4[15], k_15 = L4[63];
                f32x4 r_15 = L4[95];
                { const f32x2 bxy = (f32x2){RLF(xb, 40), RLF(xb, 41)}, bzw = (f32x2){RLF(xb, 42), RLF(xb, 43)};
                Q2[20] = Q2[20] * d_10.xy + (saq2 * bxy + vv2 * k_10.xy); Q2[21] = Q2[21] * d_10.zw + (saq2 * bzw + vv2 * k_10.zw);
                yloa += Q2[20] * r_10.xy; yhia += Q2[21] * r_10.zw; }
                { const f32x2 bxy = (f32x2){RLF(xb, 44), RLF(xb, 45)}, bzw = (f32x2){RLF(xb, 46), RLF(xb, 47)};
                Q2[22] = Q2[22] * d_11.xy + (saq2 * bxy + vv2 * k_11.xy); Q2[23] = Q2[23] * d_11.zw + (saq2 * bzw + vv2 * k_11.zw);
                ylob += Q2[22] * r_11.xy; yhib += Q2[23] * r_11.zw; }
                __builtin_amdgcn_sched_barrier(0);
                { const f32x2 bxy = (f32x2){RLF(xb, 48), RLF(xb, 49)}, bzw = (f32x2){RLF(xb, 50), RLF(xb, 51)};
                Q2[24] = Q2[24] * d_12.xy + (saq2 * bxy + vv2 * k_12.xy); Q2[25] = Q2[25] * d_12.zw + (saq2 * bzw + vv2 * k_12.zw);
                yloa += Q2[24] * r_12.xy; yhia += Q2[25] * r_12.zw; }
                { const f32x2 bxy = (f32x2){RLF(xb, 52), RLF(xb, 53)}, bzw = (f32x2){RLF(xb, 54), RLF(xb, 55)};
                Q2[26] = Q2[26] * d_13.xy + (saq2 * bxy + vv2 * k_13.xy); Q2[27] = Q2[27] * d_13.zw + (saq2 * bzw + vv2 * k_13.zw);
                ylob += Q2[26] * r_13.xy; yhib += Q2[27] * r_13.zw; }
                __builtin_amdgcn_sched_barrier(0);
                { const f32x2 bxy = (f32x2){RLF(xb, 56), RLF(xb, 57)}, bzw = (f32x2){RLF(xb, 58), RLF(xb, 59)};
                Q2[28] = Q2[28] * d_14.xy + (saq2 * bxy + vv2 * k_14.xy); Q2[29] = Q2[29] * d_14.zw + (saq2 * bzw + vv2 * k_14.zw);
                yloa += Q2[28] * r_14.xy; yhia += Q2[29] * r_14.zw; }
                { const f32x2 bxy = (f32x2){RLF(xb, 60), RLF(xb, 61)}, bzw = (f32x2){RLF(xb, 62), RLF(xb, 63)};
                Q2[30] = Q2[30] * d_15.xy + (saq2 * bxy + vv2 * k_15.xy); Q2[31] = Q2[31] * d_15.zw + (saq2 * bzw + vv2 * k_15.zw);
                ylob += Q2[30] * r_15.xy; yhib += Q2[31] * r_15.zw; }
                __builtin_amdgcn_sched_barrier(0);
                } else {
                __builtin_amdgcn_sched_barrier(0);
                DPPFMAC(qd0, xkq0, Q2[0].x, 0); DPPFMAC(pd0, xkq0, P2[0].x, 0);
                DPPFMAC(qd1, xkq0, Q2[0].y, 1); DPPFMAC(pd1, xkq0, P2[0].y, 1);
                DPPFMAC(qd2, xkq0, Q2[1].x, 2); DPPFMAC(pd2, xkq0, P2[1].x, 2);
                DPPFMAC(qd3, xkq0, Q2[1].y, 3); DPPFMAC(pd3, xkq0, P2[1].y, 3);
                DPPFMAC(qd0, xkq0, Q2[2].x, 4); DPPFMAC(pd0, xkq0, P2[2].x, 4);
                DPPFMAC(qd1, xkq0, Q2[2].y, 5); DPPFMAC(pd1, xkq0, P2[2].y, 5);
                DPPFMAC(qd2, xkq0, Q2[3].x, 6); DPPFMAC(pd2, xkq0, P2[3].x, 6);
                DPPFMAC(qd3, xkq0, Q2[3].y, 7); DPPFMAC(pd3, xkq0, P2[3].y, 7);
                DPPFMAC(qd0, xkq0, Q2[4].x, 8); DPPFMAC(pd0, xkq0, P2[4].x, 8);
                DPPFMAC(qd1, xkq0, Q2[4].y, 9); DPPFMAC(pd1, xkq0, P2[4].y, 9);
                DPPFMAC(qd2, xkq0, Q2[5].x, 10); DPPFMAC(pd2, xkq0, P2[5].x, 10);
                DPPFMAC(qd3, xkq0, Q2[5].y, 11); DPPFMAC(pd3, xkq0, P2[5].y, 11);
                DPPFMAC(qd0, xkq0, Q2[6].x, 12); DPPFMAC(pd0, xkq0, P2[6].x, 12);
                DPPFMAC(qd1, xkq0, Q2[6].y, 13); DPPFMAC(pd1, xkq0, P2[6].y, 13);
                DPPFMAC(qd2, xkq0, Q2[7].x, 14); DPPFMAC(pd2, xkq0, P2[7].x, 14);
                DPPFMAC(qd3, xkq0, Q2[7].y, 15); DPPFMAC(pd3, xkq0, P2[7].y, 15);
                __builtin_amdgcn_sched_barrier(0);
                DPPFMAC(qd0, xkq1, Q2[8].x, 0); DPPFMAC(pd0, xkq1, P2[8].x, 0);
                DPPFMAC(qd1, xkq1, Q2[8].y, 1); DPPFMAC(pd1, xkq1, P2[8].y, 1);
                DPPFMAC(qd2, xkq1, Q2[9].x, 2); DPPFMAC(pd2, xkq1, P2[9].x, 2);
                DPPFMAC(qd3, xkq1, Q2[9].y, 3); DPPFMAC(pd3, xkq1, P2[9].y, 3);
                DPPFMAC(qd0, xkq1, Q2[10].x, 4); DPPFMAC(pd0, xkq1, P2[10].x, 4);
                DPPFMAC(qd1, xkq1, Q2[10].y, 5); DPPFMAC(pd1, xkq1, P2[10].y, 5);
                DPPFMAC(qd2, xkq1, Q2[11].x, 6); DPPFMAC(pd2, xkq1, P2[11].x, 6);
                DPPFMAC(qd3, xkq1, Q2[11].y, 7); DPPFMAC(pd3, xkq1, P2[11].y, 7);
                DPPFMAC(qd0, xkq1, Q2[12].x, 8); DPPFMAC(pd0, xkq1, P2[12].x, 8);
                DPPFMAC(qd1, xkq1, Q2[12].y, 9); DPPFMAC(pd1, xkq1, P2[12].y, 9);
                DPPFMAC(qd2, xkq1, Q2[13].x, 10); DPPFMAC(pd2, xkq1, P2[13].x, 10);
                DPPFMAC(qd3, xkq1, Q2[13].y, 11); DPPFMAC(pd3, xkq1, P2[13].y, 11);
                DPPFMAC(qd0, xkq1, Q2[14].x, 12); DPPFMAC(pd0, xkq1, P2[14].x, 12);
                DPPFMAC(qd1, xkq1, Q2[14].y, 13); DPPFMAC(pd1, xkq1, P2[14].y, 13);
                DPPFMAC(qd2, xkq1, Q2[15].x, 14); DPPFMAC(pd2, xkq1, P2[15].x, 14);
                DPPFMAC(qd3, xkq1, Q2[15].y, 15); DPPFMAC(pd3, xkq1, P2[15].y, 15);
                __builtin_amdgcn_sched_barrier(0);
                DPPFMAC(qd0, xkq2, Q2[16].x, 0); DPPFMAC(pd0, xkq2, P2[16].x, 0);
                DPPFMAC(qd1, xkq2, Q2[16].y, 1); DPPFMAC(pd1, xkq2, P2[16].y, 1);
                DPPFMAC(qd2, xkq2, Q2[17].x, 2); DPPFMAC(pd2, xkq2, P2[17].x, 2);
                DPPFMAC(qd3, xkq2, Q2[17].y, 3); DPPFMAC(pd3, xkq2, P2[17].y, 3);
                DPPFMAC(qd0, xkq2, Q2[18].x, 4); DPPFMAC(pd0, xkq2, P2[18].x, 4);
                DPPFMAC(qd1, xkq2, Q2[18].y, 5); DPPFMAC(pd1, xkq2, P2[18].y, 5);
                DPPFMAC(qd2, xkq2, Q2[19].x, 6); DPPFMAC(pd2, xkq2, P2[19].x, 6);
                DPPFMAC(qd3, xkq2, Q2[19].y, 7); DPPFMAC(pd3, xkq2, P2[19].y, 7);
                DPPFMAC(qd0, xkq2, Q2[20].x, 8); DPPFMAC(pd0, xkq2, P2[20].x, 8);
                DPPFMAC(qd1, xkq2, Q2[20].y, 9); DPPFMAC(pd1, xkq2, P2[20].y, 9);
                DPPFMAC(qd2, xkq2, Q2[21].x, 10); DPPFMAC(pd2, xkq2, P2[21].x, 10);
                DPPFMAC(qd3, xkq2, Q2[21].y, 11); DPPFMAC(pd3, xkq2, P2[21].y, 11);
                DPPFMAC(qd0, xkq2, Q2[22].x, 12); DPPFMAC(pd0, xkq2, P2[22].x, 12);
                DPPFMAC(qd1, xkq2, Q2[22].y, 13); DPPFMAC(pd1, xkq2, P2[22].y, 13);
                DPPFMAC(qd2, xkq2, Q2[23].x, 14); DPPFMAC(pd2, xkq2, P2[23].x, 14);
                DPPFMAC(qd3, xkq2, Q2[23].y, 15); DPPFMAC(pd3, xkq2, P2[23].y, 15);
                __builtin_amdgcn_sched_barrier(0);
                f32x4 d_0 = L4[0], b_0 = L4[32], k_0 = L4[48];
                f32x4 d_1 = L4[1], b_1 = L4[33], k_1 = L4[49];
                DPPFMAC(qd0, xkq3, Q2[24].x, 0); DPPFMAC(pd0, xkq3, P2[24].x, 0);
                DPPFMAC(qd1, xkq3, Q2[24].y, 1); DPPFMAC(pd1, xkq3, P2[24].y, 1);
                DPPFMAC(qd2, xkq3, Q2[25].x, 2); DPPFMAC(pd2, xkq3, P2[25].x, 2);
                DPPFMAC(qd3, xkq3, Q2[25].y, 3); DPPFMAC(pd3, xkq3, P2[25].y, 3);
                DPPFMAC(qd0, xkq3, Q2[26].x, 4); DPPFMAC(pd0, xkq3, P2[26].x, 4);
                DPPFMAC(qd1, xkq3, Q2[26].y, 5); DPPFMAC(pd1, xkq3, P2[26].y, 5);
                DPPFMAC(qd2, xkq3, Q2[27].x, 6); DPPFMAC(pd2, xkq3, P2[27].x, 6);
                DPPFMAC(qd3, xkq3, Q2[27].y, 7); DPPFMAC(pd3, xkq3, P2[27].y, 7);
                DPPFMAC(qd0, xkq3, Q2[28].x, 8); DPPFMAC(pd0, xkq3, P2[28].x, 8);
                DPPFMAC(qd1, xkq3, Q2[28].y, 9); DPPFMAC(pd1, xkq3, P2[28].y, 9);
                DPPFMAC(qd2, xkq3, Q2[29].x, 10); DPPFMAC(pd2, xkq3, P2[29].x, 10);
                DPPFMAC(qd3, xkq3, Q2[29].y, 11); DPPFMAC(pd3, xkq3, P2[29].y, 11);
                DPPFMAC(qd0, xkq3, Q2[30].x, 12); DPPFMAC(pd0, xkq3, P2[30].x, 12);
                DPPFMAC(qd1, xkq3, Q2[30].y, 13); DPPFMAC(pd1, xkq3, P2[30].y, 13);
                DPPFMAC(qd2, xkq3, Q2[31].x, 14); DPPFMAC(pd2, xkq3, P2[31].x, 14);
                DPPFMAC(qd3, xkq3, Q2[31].y, 15); DPPFMAC(pd3, xkq3, P2[31].y, 15);
                { const float saq = -((qd0 + qd1) + (qd2 + qd3)), sap = -((pd0 + pd1) + (pd2 + pd3)); saq2 = (f32x2){saq, saq}; sap2 = (f32x2){sap, sap}; }
                __builtin_amdgcn_sched_barrier(0);
                f32x4 d_2 = L4[2], b_2 = L4[34], k_2 = L4[50];
                f32x4 d_3 = L4[3], b_3 = L4[35], k_3 = L4[51];
                asm volatile("s_nop 1" : "+v"(xrq0), "+v"(xrq1), "+v"(xrq2), "+v"(xrq3));
                { const f32x2 bxy = b_0.xy, bzw = b_0.zw;
                Q2[0] = Q2[0] * d_0.xy + (saq2 * bxy + vv2 * k_0.xy); Q2[1] = Q2[1] * d_0.zw + (saq2 * bzw + vv2 * k_0.zw);
                P2[0] = P2[0] * d_0.xy + sap2 * bxy; P2[1] = P2[1] * d_0.zw + sap2 * bzw;
                DPPFMAC(yd0, xrq0, Q2[0].x, 0); DPPFMAC(zd0, xrq0, P2[0].x, 0);
                DPPFMAC(yd1, xrq0, Q2[0].y, 1); DPPFMAC(zd1, xrq0, P2[0].y, 1);
                DPPFMAC(yd2, xrq0, Q2[1].x, 2); DPPFMAC(zd2, xrq0, P2[1].x, 2);
                DPPFMAC(yd3, xrq0, Q2[1].y, 3); DPPFMAC(zd3, xrq0, P2[1].y, 3);
                }
                { const f32x2 bxy = b_1.xy, bzw = b_1.zw;
                Q2[2] = Q2[2] * d_1.xy + (saq2 * bxy + vv2 * k_1.xy); Q2[3] = Q2[3] * d_1.zw + (saq2 * bzw + vv2 * k_1.zw);
                P2[2] = P2[2] * d_1.xy + sap2 * bxy; P2[3] = P2[3] * d_1.zw + sap2 * bzw;
                DPPFMAC(yd0, xrq0, Q2[2].x, 4); DPPFMAC(zd0, xrq0, P2[2].x, 4);
                DPPFMAC(yd1, xrq0, Q2[2].y, 5); DPPFMAC(zd1, xrq0, P2[2].y, 5);
                DPPFMAC(yd2, xrq0, Q2[3].x, 6); DPPFMAC(zd2, xrq0, P2[3].x, 6);
                DPPFMAC(yd3, xrq0, Q2[3].y, 7); DPPFMAC(zd3, xrq0, P2[3].y, 7);
                }
                __builtin_amdgcn_sched_barrier(0);
                f32x4 d_4 = L4[4], b_4 = L4[36], k_4 = L4[52];
                f32x4 d_5 = L4[5], b_5 = L4[37], k_5 = L4[53];
                { const f32x2 bxy = b_2.xy, bzw = b_2.zw;
                Q2[4] = Q2[4] * d_2.xy + (saq2 * bxy + vv2 * k_2.xy); Q2[5] = Q2[5] * d_2.zw + (saq2 * bzw + vv2 * k_2.zw);
                P2[4] = P2[4] * d_2.xy + sap2 * bxy; P2[5] = P2[5] * d_2.zw + sap2 * bzw;
                DPPFMAC(yd0, xrq0, Q2[4].x, 8); DPPFMAC(zd0, xrq0, P2[4].x, 8);
                DPPFMAC(yd1, xrq0, Q2[4].y, 9); DPPFMAC(zd1, xrq0, P2[4].y, 9);
                DPPFMAC(yd2, xrq0, Q2[5].x, 10); DPPFMAC(zd2, xrq0, P2[5].x, 10);
                DPPFMAC(yd3, xrq0, Q2[5].y, 11); DPPFMAC(zd3, xrq0, P2[5].y, 11);
                }
                { const f32x2 bxy = b_3.xy, bzw = b_3.zw;
                Q2[6] = Q2[6] * d_3.xy + (saq2 * bxy + vv2 * k_3.xy); Q2[7] = Q2[7] * d_3.zw + (saq2 * bzw + vv2 * k_3.zw);
                P2[6] = P2[6] * d_3.xy + sap2 * bxy; P2[7] = P2[7] * d_3.zw + sap2 * bzw;
                DPPFMAC(yd0, xrq0, Q2[6].x, 12); DPPFMAC(zd0, xrq0, P2[6].x, 12);
                DPPFMAC(yd1, xrq0, Q2[6].y, 13); DPPFMAC(zd1, xrq0, P2[6].y, 13);
                DPPFMAC(yd2, xrq0, Q2[7].x, 14); DPPFMAC(zd2, xrq0, P2[7].x, 14);
                DPPFMAC(yd3, xrq0, Q2[7].y, 15); DPPFMAC(zd3, xrq0, P2[7].y, 15);
                }
                __builtin_amdgcn_sched_barrier(0);
                f32x4 d_6 = L4[6], b_6 = L4[38], k_6 = L4[54];
                f32x4 d_7 = L4[7], b_7 = L4[39], k_7 = L4[55];
                { const f32x2 bxy = b_4.xy, bzw = b_4.zw;
                Q2[8] = Q2[8] * d_4.xy + (saq2 * bxy + vv2 * k_4.xy); Q2[9] = Q2[9] * d_4.zw + (saq2 * bzw + vv2 * k_4.zw);
                P2[8] = P2[8] * d_4.xy + sap2 * bxy; P2[9] = P2[9] * d_4.zw + sap2 * bzw;
                DPPFMAC(yd0, xrq1, Q2[8].x, 0); DPPFMAC(zd0, xrq1, P2[8].x, 0);
                DPPFMAC(yd1, xrq1, Q2[8].y, 1); DPPFMAC(zd1, xrq1, P2[8].y, 1);
                DPPFMAC(yd2, xrq1, Q2[9].x, 2); DPPFMAC(zd2, xrq1, P2[9].x, 2);
                DPPFMAC(yd3, xrq1, Q2[9].y, 3); DPPFMAC(zd3, xrq1, P2[9].y, 3);
                }
                { const f32x2 bxy = b_5.xy, bzw = b_5.zw;
                Q2[10] = Q2[10] * d_5.xy + (saq2 * bxy + vv2 * k_5.xy); Q2[11] = Q2[11] * d_5.zw + (saq2 * bzw + vv2 * k_5.zw);
                P2[10] = P2[10] * d_5.xy + sap2 * bxy; P2[11] = P2[11] * d_5.zw + sap2 * bzw;
                DPPFMAC(yd0, xrq1, Q2[10].x, 4); DPPFMAC(zd0, xrq1, P2[10].x, 4);
                DPPFMAC(yd1, xrq1, Q2[10].y, 5); DPPFMAC(zd1, xrq1, P2[10].y, 5);
                DPPFMAC(yd2, xrq1, Q2[11].x, 6); DPPFMAC(zd2, xrq1, P2[11].x, 6);
                DPPFMAC(yd3, xrq1, Q2[11].y, 7); DPPFMAC(zd3, xrq1, P2[11].y, 7);
                }
                __builtin_amdgcn_sched_barrier(0);
                f32x4 d_8 = L4[8], b_8 = L4[40], k_8 = L4[56];
                f32x4 d_9 = L4[9], b_9 = L4[41], k_9 = L4[57];
                { const f32x2 bxy = b_6.xy, bzw = b_6.zw;
                Q2[12] = Q2[12] * d_6.xy + (saq2 * bxy + vv2 * k_6.xy); Q2[13] = Q2[13] * d_6.zw + (saq2 * bzw + vv2 * k_6.zw);
                P2[12] = P2[12] * d_6.xy + sap2 * bxy; P2[13] = P2[13] * d_6.zw + sap2 * bzw;
                DPPFMAC(yd0, xrq1, Q2[12].x, 8); DPPFMAC(zd0, xrq1, P2[12].x, 8);
                DPPFMAC(yd1, xrq1, Q2[12].y, 9); DPPFMAC(zd1, xrq1, P2[12].y, 9);
                DPPFMAC(yd2, xrq1, Q2[13].x, 10); DPPFMAC(zd2, xrq1, P2[13].x, 10);
                DPPFMAC(yd3, xrq1, Q2[13].y, 11); DPPFMAC(zd3, xrq1, P2[13].y, 11);
                }
                { const f32x2 bxy = b_7.xy, bzw = b_7.zw;
                Q2[14] = Q2[14] * d_7.xy + (saq2 * bxy + vv2 * k_7.xy); Q2[15] = Q2[15] * d_7.zw + (saq2 * bzw + vv2 * k_7.zw);
                P2[14] = P2[14] * d_7.xy + sap2 * bxy; P2[15] = P2[15] * d_7.zw + sap2 * bzw;
                DPPFMAC(yd0, xrq1, Q2[14].x, 12); DPPFMAC(zd0, xrq1, P2[14].x, 12);
                DPPFMAC(yd1, xrq1, Q2[14].y, 13); DPPFMAC(zd1, xrq1, P2[14].y, 13);
                DPPFMAC(yd2, xrq1, Q2[15].x, 14); DPPFMAC(zd2, xrq1, P2[15].x, 14);
                DPPFMAC(yd3, xrq1, Q2[15].y, 15); DPPFMAC(zd3, xrq1, P2[15].y, 15);
                }
                __builtin_amdgcn_sched_barrier(0);
                f32x4 d_10 = L4[10], b_10 = L4[42], k_10 = L4[58];
                f32x4 d_11 = L4[11], b_11 = L4[43], k_11 = L4[59];
                { const f32x2 bxy = b_8.xy, bzw = b_8.zw;
                Q2[16] = Q2[16] * d_8.xy + (saq2 * bxy + vv2 * k_8.xy); Q2[17] = Q2[17] * d_8.zw + (saq2 * bzw + vv2 * k_8.zw);
                P2[16] = P2[16] * d_8.xy + sap2 * bxy; P2[17] = P2[17] * d_8.zw + sap2 * bzw;
                DPPFMAC(yd0, xrq2, Q2[16].x, 0); DPPFMAC(zd0, xrq2, P2[16].x, 0);
                DPPFMAC(yd1, xrq2, Q2[16].y, 1); DPPFMAC(zd1, xrq2, P2[16].y, 1);
                DPPFMAC(yd2, xrq2, Q2[17].x, 2); DPPFMAC(zd2, xrq2, P2[17].x, 2);
                DPPFMAC(yd3, xrq2, Q2[17].y, 3); DPPFMAC(zd3, xrq2, P2[17].y, 3);
                }
                { const f32x2 bxy = b_9.xy, bzw = b_9.zw;
                Q2[18] = Q2[18] * d_9.xy + (saq2 * bxy + vv2 * k_9.xy); Q2[19] = Q2[19] * d_9.zw + (saq2 * bzw + vv2 * k_9.zw);
                P2[18] = P2[18] * d_9.xy + sap2 * bxy; P2[19] = P2[19] * d_9.zw + sap2 * bzw;
                DPPFMAC(yd0, xrq2, Q2[18].x, 4); DPPFMAC(zd0, xrq2, P2[18].x, 4);
                DPPFMAC(yd1, xrq2, Q2[18].y, 5); DPPFMAC(zd1, xrq2, P2[18].y, 5);
                DPPFMAC(yd2, xrq2, Q2[19].x, 6); DPPFMAC(zd2, xrq2, P2[19].x, 6);
                DPPFMAC(yd3, xrq2, Q2[19].y, 7); DPPFMAC(zd3, xrq2, P2[19].y, 7);
                }
                __builtin_amdgcn_sched_barrier(0);
                f32x4 d_12 = L4[12], b_12 = L4[44], k_12 = L4[60];
                f32x4 d_13 = L4[13], b_13 = L4[45], k_13 = L4[61];
                { const f32x2 bxy = b_10.xy, bzw = b_10.zw;
                Q2[20] = Q2[20] * d_10.xy + (saq2 * bxy + vv2 * k_10.xy); Q2[21] = Q2[21] * d_10.zw + (saq2 * bzw + vv2 * k_10.zw);
                P2[20] = P2[20] * d_10.xy + sap2 * bxy; P2[21] = P2[21] * d_10.zw + sap2 * bzw;
                DPPFMAC(yd0, xrq2, Q2[20].x, 8); DPPFMAC(zd0, xrq2, P2[20].x, 8);
                DPPFMAC(yd1, xrq2, Q2[20].y, 9); DPPFMAC(zd1, xrq2, P2[20].y, 9);
                DPPFMAC(yd2, xrq2, Q2[21].x, 10); DPPFMAC(zd2, xrq2, P2[21].x, 10);
                DPPFMAC(yd3, xrq2, Q2[21].y, 11); DPPFMAC(zd3, xrq2, P2[21].y, 11);
                }
                { const f32x2 bxy = b_11.xy, bzw = b_11.zw;
                Q2[22] = Q2[22] * d_11.xy + (saq2 * bxy + vv2 * k_11.xy); Q2[23] = Q2[23] * d_11.zw + (saq2 * bzw + vv2 * k_11.zw);
                P2[22] = P2[22] * d_11.xy + sap2 * bxy; P2[23] = P2[23] * d_11.zw + sap2 * bzw;
                DPPFMAC(yd0, xrq2, Q2[22].x, 12); DPPFMAC(zd0, xrq2, P2[22].x, 12);
                DPPFMAC(yd1, xrq2, Q2[22].y, 13); DPPFMAC(zd1, xrq2, P2[22].y, 13);
                DPPFMAC(yd2, xrq2, Q2[23].x, 14); DPPFMAC(zd2, xrq2, P2[23].x, 14);
                DPPFMAC(yd3, xrq2, Q2[23].y, 15); DPPFMAC(zd3, xrq2, P2[23].y, 15);
                }
                __builtin_amdgcn_sched_barrier(0);
                f32x4 d_14 = L4[14], b_14 = L4[46], k_14 = L4[62];
                f32x4 d_15 = L4[15], b_15 = L4[47], k_15 = L4[63];
                { const f32x2 bxy = b_12.xy, bzw = b_12.zw;
                Q2[24] = Q2[24] * d_12.xy + (saq2 * bxy + vv2 * k_12.xy); Q2[25] = Q2[25] * d_12.zw + (saq2 * bzw + vv2 * k_12.zw);
                P2[24] = P2[24] * d_12.xy + sap2 * bxy; P2[25] = P2[25] * d_12.zw + sap2 * bzw;
                DPPFMAC(yd0, xrq3, Q2[24].x, 0); DPPFMAC(zd0, xrq3, P2[24].x, 0);
                DPPFMAC(yd1, xrq3, Q2[24].y, 1); DPPFMAC(zd1, xrq3, P2[24].y, 1);
                DPPFMAC(yd2, xrq3, Q2[25].x, 2); DPPFMAC(zd2, xrq3, P2[25].x, 2);
                DPPFMAC(yd3, xrq3, Q2[25].y, 3); DPPFMAC(zd3, xrq3, P2[25].y, 3);
                }
                { const f32x2 bxy = b_13.xy, bzw = b_13.zw;
                Q2[26] = Q2[26] * d_13.xy + (saq2 * bxy + vv2 * k_13.xy); Q2[27] = Q2[27] * d_13.zw + (saq2 * bzw + vv2 * k_13.zw);
                P2[26] = P2[26] * d_13.xy + sap2 * bxy; P2[27] = P2[27] * d_13.zw + sap2 * bzw;
                DPPFMAC(yd0, xrq3, Q2[26].x, 4); DPPFMAC(zd0, xrq3, P2[26].x, 4);
                DPPFMAC(yd1, xrq3, Q2[26].y, 5); DPPFMAC(zd1, xrq3, P2[26].y, 5);
                DPPFMAC(yd2, xrq3, Q2[27].x, 6); DPPFMAC(zd2, xrq3, P2[27].x, 6);
                DPPFMAC(yd3, xrq3, Q2[27].y, 7); DPPFMAC(zd3, xrq3, P2[27].y, 7);
                }
                __builtin_amdgcn_sched_barrier(0);
                { const f32x2 bxy = b_14.xy, bzw = b_14.zw;
                Q2[28] = Q2[28] * d_14.xy + (saq2 * bxy + vv2 * k_14.xy); Q2[29] = Q2[29] * d_14.zw + (saq2 * bzw + vv2 * k_14.zw);
                P2[28] = P2[28] * d_14.xy + sap2 * bxy; P2[29] = P2[29] * d_14.zw + sap2 * bzw;
                DPPFMAC(yd0, xrq3, Q2[28].x, 8); DPPFMAC(zd0, xrq3, P2[28].x, 8);
                DPPFMAC(yd1, xrq3, Q2[28].y, 9); DPPFMAC(zd1, xrq3, P2[28].y, 9);
                DPPFMAC(yd2, xrq3, Q2[29].x, 10); DPPFMAC(zd2, xrq3, P2[29].x, 10);
                DPPFMAC(yd3, xrq3, Q2[29].y, 11); DPPFMAC(zd3, xrq3, P2[29].y, 11);
                }
                { const f32x2 bxy = b_15.xy, bzw = b_15.zw;
                Q2[30] = Q2[30] * d_15.xy + (saq2 * bxy + vv2 * k_15.xy); Q2[31] = Q2[31] * d_15.zw + (saq2 * bzw + vv2 * k_15.zw);
                P2[30] = P2[30] * d_15.xy + sap2 * bxy; P2[31] = P2[31] * d_15.zw + sap2 * bzw;
                DPPFMAC(yd0, xrq3, Q2[30].x, 12); DPPFMAC(zd0, xrq3, P2[30].x, 12);
                DPPFMAC(yd1, xrq3, Q2[30].y, 13); DPPFMAC(zd1, xrq3, P2[30].y, 13);
                DPPFMAC(yd2, xrq3, Q2[31].x, 14); DPPFMAC(zd2, xrq3, P2[31].x, 14);
                DPPFMAC(yd3, xrq3, Q2[31].y, 15); DPPFMAC(zd3, xrq3, P2[31].y, 15);
                }
                __builtin_amdgcn_sched_barrier(0);
                }
                if (!PASS2 && MODE == 0) {
                    const unsigned ox = i0 + (unsigned)((seg * SB + s) * DB);
                    YT[ox] = (yd0 + yd1) + (yd2 + yd3); ZT[ox] = (bf16)f2bf((zd0 + zd1) + (zd2 + zd3));
                }
                if (PASS2) {
                    const f32x2 ys = (yloa + ylob) + (yhia + yhib);
                    const float y = ys.x + ys.y;
                    float s1 = y, s2 = y * y; wave_sum2(s1, s2);
                    const float mean = s1 * (1.0f / 64.0f); const float var = fmaxf(s2 * (1.0f / 64.0f) - mean * mean, 0.f);
                    const float yn = (y - mean) * (1.0f / sqrtf(var + 64e-5f)) * lw + lb;
                    const float o = (yn + sv[7 * 64 + lane] * vv) * sv[6 * 64 + lane];
                    YB[i0 + (unsigned)((seg * SB + s) * DB)] = (bf16)f2bf(o);
                }
            }
            asm volatile("" ::: "memory");
            if (MODE != 2 && seg + 1 < CL / SB) SCAN_STORE(bi ^ 1, seg + 1);
            asm volatile("" ::: "memory");
        }
#undef SCAN_LOAD
#undef SCAN_STORE
        if (MODE != 0) { float acc_ = 0.f; _Pragma("unroll") for (int k = 0; k < 32; ++k) acc_ += Q2[k].x + Q2[k].y + P2[k].x + P2[k].y; if (acc_ == 123.456f) ST[0] = acc_; }
        if (!PASS2 && MODE == 0) { f32x4* sq = (f32x4*)(ST + ((size_t)u * 2) * 4096 + lane * 64); f32x4* sp = (f32x4*)(ST + ((size_t)u * 2 + 1) * 4096 + lane * 64);
#pragma unroll
            for (int j = 0; j < 16; ++j) { sq[j] = (f32x4){Q2[2 * j].x, Q2[2 * j].y, Q2[2 * j + 1].x, Q2[2 * j + 1].y}; sp[j] = (f32x4){P2[2 * j].x, P2[2 * j].y, P2[2 * j + 1].x, P2[2 * j + 1].y}; } }
    }
}

#define DPPR(v, ctrl) __int_as_float(__builtin_amdgcn_update_dpp(0, __float_as_int(v), ctrl, 0xf, 0xf, false))
__device__ __forceinline__ float row16_allsum(float v) { v += DPPR(v, 0xB1); v += DPPR(v, 0x4E); v += DPPR(v, 0x141); v += DPPR(v, 0x140); return v; }
struct P2Tile { u32x4 z0, z1; f32x4 yt[4]; u32x2 vv[4], gg[4]; float bo; };
__device__ __forceinline__ void phase_scan2z(const Params& p) {
    const int tid = threadIdx.x, lane = tid & 63, wave = tid >> 6, G = gridDim.x;
    const int gw = blockIdx.x * NWAVES + wave, NGW = G * NWAVES;
    unsigned char* ws = p.ws;
    const bf16* V = (const bf16*)p.out + (size_t)2 * T * DB; const bf16* Gt = (const bf16*)(ws + WS_G); const float* BON = (const float*)(ws + WS_BONUS); bf16* YB = (bf16*)(ws + WS_YB);
    const float* ST = (const float*)(ws + WS_ST); const float* YT = (const float*)p.out; const bf16* ZT = (const bf16*)p.out + (size_t)3 * T * DB;
    for (int u = gw; u < 32 * NCH; u += NGW) {
        const int bh = u / NCH, ch = u % NCH, b = bh >> 4, h = bh & 15; int lnl = lane; asm volatile("" : "+v"(lnl));
        const int lr = lnl & 15, lq = lnl >> 4;
        const unsigned t00 = (unsigned)(b * SEQ + ch * CL);
        bf16x8 Sf[4][2];
#pragma unroll
        for (int c = 0; c < 4; ++c)
#pragma unroll
            for (int ks = 0; ks < 2; ++ks) { u32x4 w = (u32x4){0u, 0u, 0u, 0u};
                if (ch > 0) { const float* sp = ST + ((size_t)(u - 1) * 2) * 4096 + (16 * c + lr) * 64 + 32 * ks + 8 * lq; const f32x4 x0 = *(const f32x4*)sp, x1 = *(const f32x4*)(sp + 4);
                    w.x = pk2(x0[0], x0[1]); w.y = pk2(x0[2], x0[3]); w.z = pk2(x1[0], x1[1]); w.w = pk2(x1[2], x1[3]); }
                Sf[c][ks] = __builtin_bit_cast(bf16x8, w); }
        f32x4 lw[4], lb[4];
#pragma unroll
        for (int c = 0; c < 4; ++c) { lw[c] = *(const f32x4*)(p.in[I_LNW] + h * 64 + 16 * c + 4 * lq); lb[c] = *(const f32x4*)(p.in[I_LNB] + h * 64 + 16 * c + 4 * lq); }
#define P2_LOAD(D, tt) do { const unsigned ta_ = t00 + 16u * (tt) + lr; const bf16* zp_ = ZT + (size_t)ta_ * DB + h * 64 + 8 * lq; (D).z0 = *(const u32x4*)zp_; (D).z1 = *(const u32x4*)(zp_ + 32); \
            const size_t o_ = (size_t)ta_ * DB + h * 64 + 4 * lq; (D).bo = BON[ta_ * NH + h]; \
            _Pragma("unroll") for (int c = 0; c < 4; ++c) { (D).yt[c] = *(const f32x4*)(YT + o_ + 16 * c); (D).vv[c] = *(const u32x2*)(V + o_ + 16 * c); (D).gg[c] = *(const u32x2*)(Gt + o_ + 16 * c); } } while (0)
#define P2_COMP(D, tt) do { f32x4 y_[4]; const bf16x8 b0_ = __builtin_bit_cast(bf16x8, (D).z0), b1_ = __builtin_bit_cast(bf16x8, (D).z1); float s1_ = 0.f, s2_ = 0.f; \
            _Pragma("unroll") for (int c = 0; c < 4; ++c) { f32x4 a_ = __builtin_amdgcn_mfma_f32_16x16x32_bf16(Sf[c][0], b0_, (f32x4){0.f, 0.f, 0.f, 0.f}, 0, 0, 0); a_ = __builtin_amdgcn_mfma_f32_16x16x32_bf16(Sf[c][1], b1_, a_, 0, 0, 0); \
                y_[c] = a_ + (D).yt[c]; s1_ += (y_[c][0] + y_[c][1]) + (y_[c][2] + y_[c][3]); s2_ += (y_[c][0] * y_[c][0] + y_[c][1] * y_[c][1]) + (y_[c][2] * y_[c][2] + y_[c][3] * y_[c][3]); } \
            s1_ += __shfl_xor(s1_, 16); s2_ += __shfl_xor(s2_, 16); s1_ += __shfl_xor(s1_, 32); s2_ += __shfl_xor(s2_, 32); \
            const float mean_ = s1_ * (1.0f / 64.0f), rs_ = 1.0f / sqrtf(fmaxf(s2_ * (1.0f / 64.0f) - mean_ * mean_, 0.f) + 64e-5f); \
            const size_t o_ = (size_t)(t00 + 16u * (tt) + lr) * DB + h * 64 + 4 * lq; \
            _Pragma("unroll") for (int c = 0; c < 4; ++c) { const u32x2 vw_ = (D).vv[c], gw_ = (D).gg[c]; \
                const f32x4 v4_ = (f32x4){__uint_as_float(vw_.x << 16), __uint_as_float(vw_.x & 0xffff0000u), __uint_as_float(vw_.y << 16), __uint_as_float(vw_.y & 0xffff0000u)}; \
                const f32x4 g4_ = (f32x4){__uint_as_float(gw_.x << 16), __uint_as_float(gw_.x & 0xffff0000u), __uint_as_float(gw_.y << 16), __uint_as_float(gw_.y & 0xffff0000u)}; \
                const f32x4 o4_ = ((y_[c] - mean_) * rs_ * lw[c] + lb[c] + v4_ * (D).bo) * g4_; u32x2 w_; w_.x = pk2(o4_[0], o4_[1]); w_.y = pk2(o4_[2], o4_[3]); *(u32x2*)(YB + o_ + 16 * c) = w_; } } while (0)
        P2Tile A, B;
        P2_LOAD(A, 0);
#pragma unroll 1
        for (int tt = 0; tt < CL / 16; tt += 2) {
            P2_LOAD(B, tt + 1);
            P2_COMP(A, tt);
            if (tt + 2 < CL / 16) P2_LOAD(A, tt + 2);
            P2_COMP(B, tt + 1);
        }
#undef P2_LOAD
#undef P2_COMP
    }
}

__device__ __forceinline__ void phase_combine(const Params& p, LAS unsigned char* lds) {
    const int tid = threadIdx.x, lane = tid & 63, wave = tid >> 6, G = gridDim.x;
    float* ST = (float*)(p.ws + WS_ST);
    LAS float* PL = (LAS float*)lds;
    if (G > 128 && (int)blockIdx.x >= 128) { convert_weights<1>(p, lds, ((int)blockIdx.x - 128) * NWAVES + wave, (G - 128) * NWAVES); return; }
    for (int bu = blockIdx.x; bu < 32 * 4; bu += G) {
        const int bh = bu >> 2, rq = bu & 3, r0 = rq * 16 + wave * 2;
        const float* base = ST + ((size_t)(bh * NCH) * 2) * 4096;
        float s0 = base[(r0) * 64 + lane], s1 = base[(r0 + 1) * 64 + lane];
        f32x4 pr0, pr1; float q0n, q1n;
        __syncthreads();
        { const f32x4* pp = (const f32x4*)(base + 1 * 8192 + 4096); pr0 = pp[tid]; pr1 = pp[tid + 512]; q0n = base[1 * 8192 + (r0) * 64 + lane]; q1n = base[1 * 8192 + (r0 + 1) * 64 + lane]; }
        *(LAS f32x4*)(PL + 4096 + tid * 4) = pr0; *(LAS f32x4*)(PL + 4096 + (tid + 512) * 4) = pr1;
        __syncthreads();
        for (int c = 1; c < NCH - 1; ++c) {
            const LAS float* Pc = PL + (c & 1) * 4096;
            float n0 = q0n, n1 = q1n;
            if (c + 1 < NCH - 1) { const f32x4* pp = (const f32x4*)(base + (size_t)(c + 1) * 8192 + 4096); pr0 = pp[tid]; pr1 = pp[tid + 512];
                q0n = base[(size_t)(c + 1) * 8192 + (r0) * 64 + lane]; q1n = base[(size_t)(c + 1) * 8192 + (r0 + 1) * 64 + lane]; }
            float a0 = 0.f, a1 = 0.f, b0 = 0.f, b1 = 0.f;
#pragma unroll
            for (int k = 0; k < 64; k += 2) { const float pk0 = Pc[k * 64 + lane], pk1 = Pc[(k + 1) * 64 + lane];
                a0 += __int_as_float(__builtin_amdgcn_readlane(__float_as_int(s0), k)) * pk0; b0 += __int_as_float(__builtin_amdgcn_readlane(__float_as_int(s0), k + 1)) * pk1;
                a1 += __int_as_float(__builtin_amdgcn_readlane(__float_as_int(s1), k)) * pk0; b1 += __int_as_float(__builtin_amdgcn_readlane(__float_as_int(s1), k + 1)) * pk1; }
            s0 = n0 + (a0 + b0); s1 = n1 + (a1 + b1);
            float* Qc = ST + ((size_t)(bh * NCH + c) * 2) * 4096;
            Qc[(r0) * 64 + lane] = s0; Qc[(r0 + 1) * 64 + lane] = s1;
            if (c + 1 < NCH - 1) { LAS float* Pn = PL + ((c + 1) & 1) * 4096; *(LAS f32x4*)(Pn + tid * 4) = pr0; *(LAS f32x4*)(Pn + (tid + 512) * 4) = pr1; }
            __syncthreads();
        }
    }
}

__device__ __forceinline__ void phase_fixup(const Params& p) {
    const int tid = threadIdx.x, G = gridDim.x; unsigned char* ws = p.ws;
    const float* TOP = (const float*)(ws + WS_TOP); const float* BOT = (const float*)(ws + WS_BOT); bf16* ACT = (bf16*)(ws + WS_ACT);
    const float* cw = p.in[I_CW];
    const int gt = blockIdx.x * NTHR + tid, NGT = G * NTHR;
    for (int i0 = gt; i0 < 128 * 2 * DFF; i0 += 4 * NGT) {
        float Cg[4], Cv[4], bg0[4], bg1[4], bv0[4], bv1[4];
#pragma unroll
        for (int u = 0; u < 4; ++u) { const int i = i0 + u * NGT; Cg[u] = Cv[u] = bg0[u] = bg1[u] = bv0[u] = bv1[u] = 0.f;
            if (i < 128 * 2 * DFF) { const int j = i % DFF, row = (i / DFF) & 1, pm = i / (2 * DFF); const int cg_ = (j >> 7) * 256 + (j & 127), cv_ = cg_ + 128;
                Cg[u] = TOP[((size_t)pm * 2 + row) * 11264 + cg_]; Cv[u] = TOP[((size_t)pm * 2 + row) * 11264 + cv_];
                if (pm % 64) { const float* b0 = BOT + ((size_t)(pm - 1) * 2) * 11264; const float* b1 = b0 + 11264; bg0[u] = b0[cg_]; bg1[u] = b1[cg_]; bv0[u] = b0[cv_]; bv1[u] = b1[cv_]; } } }
#pragma unroll
        for (int u = 0; u < 4; ++u) { const int i = i0 + u * NGT;
            if (i < 128 * 2 * DFF) { const int j = i % DFF, row = (i / DFF) & 1, pm = i / (2 * DFF); float g = Cg[u], v = Cv[u];
                if (pm % 64) { if (row == 0) { g += cw[j] * bg0[u] + cw[11264 + j] * bg1[u]; v += cw[5632 + j] * bv0[u] + cw[11264 + 5632 + j] * bv1[u]; }
                               else { g += cw[j] * bg1[u]; v += cw[5632 + j] * bv1[u]; } }
                ACT[(size_t)(pm * 256 + row) * DFF + j] = (bf16)f2bf(gelu_f(g) * v); } } }
}

__device__ __forceinline__ void phase_final(const Params& p) {
    const int tid = threadIdx.x, lane = tid & 63, wave = tid >> 6, G = gridDim.x;
    const int gw = blockIdx.x * NWAVES + wave, NGW = G * NWAVES;
    const float* ssq = (const float*)(p.ws + WS_SSQ2); const f32x4* gr = (const f32x4*)p.in[I_NFG] + lane;
    f32x4 g4[8];
#pragma unroll
    for (int j = 0; j < 8; ++j) g4[j] = gr[64 * j];
    constexpr int UR = 4;
    for (int row0 = gw; row0 < T; row0 += UR * NGW) { f32x4 v[UR][8]; float rs[UR];
#pragma unroll
        for (int u = 0; u < UR; ++u) { const int row = row0 + u * NGW; const f32x4* xr = (const f32x4*)(p.out + (size_t)row * DM) + lane;
#pragma unroll
            for (int j = 0; j < 8; ++j) v[u][j] = xr[64 * j];
            const f32x4* sp = (const f32x4*)(ssq + (size_t)row * 32); f32x4 s = sp[0];
#pragma unroll
            for (int i = 1; i < 8; ++i) s += sp[i];
            rs[u] = 1.0f / sqrtf(((s[0] + s[1]) + (s[2] + s[3])) * (1.0f / DM) + 1e-6f); }
#pragma unroll
        for (int u = 0; u < UR; ++u) { f32x4* xr = (f32x4*)(p.out + (size_t)(row0 + u * NGW) * DM) + lane;
#pragma unroll
            for (int j = 0; j < 8; ++j) __builtin_nontemporal_store(v[u][j] * rs[u] * g4[j], xr + 64 * j); } }
}

#define XB_TMO      128
#define XB_XCNT(j)  (256  + 64 * (j))
#define XB_XSUB(j)  (1280 + 64 * (j))
#define XB_XGEN(j)  (2304 + 64 * (j))
#define XB_TOP      3328
#define XB_TOPGEN   3392
#define XCD_BAR_WORDS 3456
#define XB_SPIN_CAP (1u << 18)

__device__ __forceinline__ unsigned xb_ld(unsigned* p)              { return __hip_atomic_load(p, __ATOMIC_RELAXED, __HIP_MEMORY_SCOPE_AGENT); }
__device__ __forceinline__ unsigned xb_add(unsigned* p, unsigned v) { return __hip_atomic_fetch_add(p, v, __ATOMIC_RELAXED, __HIP_MEMORY_SCOPE_AGENT); }
__device__ __forceinline__ unsigned xb_xcc_id() { return (unsigned)__builtin_amdgcn_s_getreg((3 << 11) | 20) & 0xFu; }
#define XB_SPIN(cond, bar) do { unsigned _sp = 0; while (cond) { __builtin_amdgcn_s_sleep(1); \
    if ((++_sp & 255u) == 0u) { if (xb_ld(&(bar)[XB_TMO])) break; if (_sp > XB_SPIN_CAP) { atomicAdd(&(bar)[XB_TMO], 1u); break; } } } } while (0)

struct XcdBarrier {
    unsigned* bar; unsigned x;
    volatile LAS unsigned* st;
};

__device__ __forceinline__ XcdBarrier xcd_barrier_post(unsigned* bar, volatile LAS unsigned* st) {
    XcdBarrier b; b.bar = bar; b.x = xb_xcc_id(); b.st = st;
    if (threadIdx.x == 0) (void)xb_add(&bar[XB_XCNT(b.x)], 1u);
    return b;
}
__device__ __forceinline__ void xcd_barrier_complete(unsigned* bar, unsigned x, unsigned& nloc, unsigned& nx) {
    const unsigned G = gridDim.x * gridDim.y * gridDim.z;
    unsigned sum, cnt, mine, sp = 0u;
    for (;;) {
        sum = 0u; cnt = 0u; mine = 0u;
#pragma unroll
        for (unsigned j = 0; j < 16; ++j) { const unsigned c = xb_ld(&bar[XB_XCNT(j)]); sum += c; cnt += (c > 0u) ? 1u : 0u; mine = (j == x) ? c : mine; }
        if (sum == G) break;
        __builtin_amdgcn_s_sleep(1);
        if ((++sp & 255u) == 0u) { if (xb_ld(&bar[XB_TMO])) break; if (sp > XB_SPIN_CAP) { atomicAdd(&bar[XB_TMO], 1u); break; } }
    }
    nloc = mine > 0u ? mine : 1u; nx = cnt > 0u ? cnt : 1u;
}

__device__ __forceinline__ void xcd_barrier(const XcdBarrier& b) {
    asm volatile("s_waitcnt vmcnt(0)" ::: "memory");
    __syncthreads();
    if (threadIdx.x == 0) {
        unsigned* bar = b.bar;
        __builtin_amdgcn_s_waitcnt(0);
        unsigned nloc = b.st[0], nx = b.st[1];
        if (nloc == 0u) { xcd_barrier_complete(bar, b.x, nloc, nx); b.st[0] = nloc; b.st[1] = nx; }
        const unsigned old = xb_add(&bar[XB_XSUB(b.x)], 1u);
        const unsigned gen = old / nloc;
        if (old + 1u == (gen + 1u) * nloc) {
            __builtin_amdgcn_fence(__ATOMIC_RELEASE, "agent");
            asm volatile("s_waitcnt vmcnt(0)" ::: "memory");
            const unsigned og = xb_add(&bar[XB_TOP], 1u);
            const unsigned tg = og / nx;
            if (og + 1u == (tg + 1u) * nx) xb_add(&bar[XB_TOPGEN], 1u);
            else XB_SPIN(xb_ld(&bar[XB_TOPGEN]) == tg, bar);
            __builtin_amdgcn_fence(__ATOMIC_ACQUIRE, "agent");
            xb_add(&bar[XB_XGEN(b.x)], 1u);
            asm volatile("s_waitcnt vmcnt(0)" ::: "memory");
        } else {
            XB_SPIN(xb_ld(&bar[XB_XGEN(b.x)]) == gen, bar);
            __builtin_amdgcn_fence(__ATOMIC_ACQUIRE, "agent");
            asm volatile("s_waitcnt vmcnt(0)" ::: "memory");
        }
    }
    __syncthreads();
}

constexpr int N_PHASES = 15;
__global__ void __launch_bounds__(NTHR, 2) fwd_kernel(Params p) {
    extern __shared__ __attribute__((aligned(16))) unsigned char lds_raw[];
    LAS unsigned char* lds = (LAS unsigned char*)lds_raw;
    cg::grid_group grid = cg::this_grid();
    unsigned char* ws = p.ws; const int G = gridDim.x, bx = blockIdx.x;
    const float* rstd1 = (const float*)(ws + WS_RSTD1);
#define IN(k) (p.ph_lo <= (k) && (k) < p.ph_hi)
    for (int u_ = threadIdx.x; u_ < 256; u_ += NTHR) ((LAS unsigned*)(lds + 143360))[u_] = 0u;
    __syncthreads();
    XcdBarrier xbar = xcd_barrier_post((unsigned*)(ws + WS_BAR), (volatile LAS unsigned*)(lds + 143360 + 64));
#define SEAM(k) do { if (IN(k) && IN((k) + 1)) { if ((k) == 0) grid.sync(); else xcd_barrier(xbar); } } while (0)
#ifndef PROBE_DUP
#define PROBE_DUP 0
#endif
#define PH(k) if (IN(k)) for (int rep_ = 0; rep_ <= ((PROBE_DUP >> (k)) & 1); ++rep_)
    PH(0) { if (rep_) xcd_barrier(xbar); phase_prologue(p, lds); } SEAM(0);
    PH(1) { if (rep_) xcd_barrier(xbar); pg8::Gemm g{(const bf16*)(ws + WS_XB), (const bf16*)(ws + WS_W_IN), T, N_IN1, DM}; pg8::StaticOrder S; S.init(T, N_IN1, G, bx);
        pg8::EpiIn E{(bf16*)(ws + WS_AU), (bf16*)(ws + WS_AV), (bf16*)(ws + WS_FEAT), (bf16*)(ws + WS_LRAW), rstd1, (float*)(ws + WS_SSQ2)};
        pg8::gemm_phase<pg8::EpiIn, pg8::StaticOrder, true, true>(lds, g, S, E); } SEAM(1);
    PH(2) { if (rep_) xcd_barrier(xbar); phase_gmlp(p, lds); } SEAM(2);
    PH(3) { if (rep_) xcd_barrier(xbar); int kl = K_LORA; asm volatile("" : "+s"(kl)); pg8::Gemm g{(const bf16*)(ws + WS_LIN), (const bf16*)(ws + WS_W_LORA), T, N_LORA, kl}; pg8::StaticOrder S; S.init(T, N_LORA, G, bx);
        pg8::EpiLora E{(float*)(ws + WS_DEC), (bf16*)(ws + WS_AS), (bf16*)(ws + WS_G), p.in[I_W0], p.in[I_A0]};
        pg8::gemm_phase<pg8::EpiLora, pg8::StaticOrder, true, true>(lds, g, S, E); } SEAM(3);
    PH(5) { if (rep_) xcd_barrier(xbar); phase_scan<false>(p, lds); } SEAM(5);
    PH(6) { if (rep_) xcd_barrier(xbar); phase_combine(p, lds); } SEAM(6);
    PH(7) { if (rep_) xcd_barrier(xbar); phase_scan2z(p); } SEAM(7);
    PH(8) { if (rep_) xcd_barrier(xbar);
        { pg8::Gemm g{(const bf16*)(ws + WS_XB), (const bf16*)(ws + WS_W_IN) + (size_t)N_IN1 * DM, T, N_GATE, DM}; pg8::StaticOrder S; S.init(T, N_GATE, G, bx);
          pg8::EpiGate E{(bf16*)p.out, rstd1};
          pg8::gemm_phase<pg8::EpiGate, pg8::StaticOrder, true, true>(lds, g, S, E); }
        { pg8::Gemm g{(const bf16*)(ws + WS_YA), (const bf16*)(ws + WS_W_PA), T, DM, DA}; pg8::StaticOrder S; S.init(T, DM, G, bx);
          pg8::EpiPlain E{(bf16*)(ws + WS_PA)};
          pg8::gemm_phase<pg8::EpiPlain, pg8::StaticOrder, true, true>(lds, g, S, E); } } SEAM(8);
    PH(9) { if (rep_) xcd_barrier(xbar); pg8::Gemm g{(const bf16*)(ws + WS_YB), (const bf16*)(ws + WS_W_PB), T, DM, DB}; pg8::StaticOrder S; S.init(T, DM, G, bx);
        pg8::EpiMerge E{(const bf16*)p.out, (const bf16*)(ws + WS_PA), (bf16*)(ws + WS_MERGED)};
        pg8::gemm_phase<pg8::EpiMerge, pg8::StaticOrder, true, true>(lds, g, S, E); } SEAM(9);
    PH(10) { if (rep_) xcd_barrier(xbar); pg8::Gemm g{(const bf16*)(ws + WS_MERGED), (const bf16*)(ws + WS_W_OUT), T, DM, DM}; pg8::StaticOrder S; S.init(T, DM, G, bx);
        pg8::EpiRes<false> E{(const bf16*)(ws + WS_XB), nullptr, (bf16*)(ws + WS_XB), (float*)(ws + WS_SSQ1)};
        pg8::gemm_phase<pg8::EpiRes<false>, pg8::StaticOrder, true, true>(lds, g, S, E); } SEAM(10);
    PH(11) { if (rep_) xcd_barrier(xbar); pg8::Gemm g{(const bf16*)(ws + WS_XB), (const bf16*)(ws + WS_W_UP), T, 2 * DFF, DM}; pg8::StaticOrder S; S.init(T, 2 * DFF, G, bx);
        pg8::EpiUp E{(bf16*)(ws + WS_ACT), (const float*)(ws + WS_SSQ1), p.in[I_CW], p.in[I_CB], (float*)(ws + WS_TOP), (float*)(ws + WS_BOT), lds + EPI_OFF};
        pg8::gemm_phase<pg8::EpiUp, pg8::StaticOrder, true, true>(lds, g, S, E); } SEAM(11);
    PH(12) { if (rep_) xcd_barrier(xbar); phase_fixup(p); } SEAM(12);
    PH(13) { if (rep_) xcd_barrier(xbar); pg8::Gemm g{(const bf16*)(ws + WS_ACT), (const bf16*)(ws + WS_W_DOWN), T, DM, DFF}; pg8::StaticOrder S; S.init(T, DM, G, bx);
        pg8::EpiRes<true> E{(const bf16*)(ws + WS_XB), p.out, nullptr, (float*)(ws + WS_SSQ2)};
        pg8::gemm_phase<pg8::EpiRes<true>, pg8::StaticOrder, true, true>(lds, g, S, E); } SEAM(13);
    PH(14) { if (rep_) xcd_barrier(xbar); phase_final(p); }
#undef IN
#undef PH
#undef SEAM
}

#ifndef MK_PER_PHASE
#define MK_PER_PHASE 0
#endif
extern "C" void kernel_launch(void* const* d_in, const int* in_sizes, int n_in, void* d_out, int out_size, void* d_ws, size_t ws_size, hipStream_t stream) {
    static int grid = 0;
    if (grid == 0) {
        if (n_in != 27 || out_size != T * DM || ws_size < WS_END) { fprintf(stderr, "kernel_launch: unexpected shapes (n_in %d, out %d, ws %zu < %zu)\n", n_in, out_size, ws_size, (size_t)WS_END); grid = -1; return; }
        int dev = 0, cus = 0, per_cu = 0;
        hipGetDevice(&dev); hipDeviceGetAttribute(&cus, hipDeviceAttributeMultiprocessorCount, dev);
        hipFuncSetAttribute((const void*)fwd_kernel, hipFuncAttributeMaxDynamicSharedMemorySize, LDS_BYTES);
        hipOccupancyMaxActiveBlocksPerMultiprocessor(&per_cu, (const void*)fwd_kernel, NTHR, LDS_BYTES);
        if (per_cu < 1) { fprintf(stderr, "kernel_launch: occupancy query says %d blocks per CU\n", per_cu); per_cu = 1; }
        (void)hipGetLastError();
        grid = cus;
    }
    if (grid < 0) return;
    Params p{};
    for (int i = 0; i < 27; ++i) p.in[i] = (const float*)d_in[i];
    p.out = (float*)d_out; p.ws = (unsigned char*)d_ws;
#if MK_PER_PHASE
    for (int ph = 0; ph < N_PHASES; ++ph) { p.ph_lo = ph; p.ph_hi = ph + 1; hipLaunchKernelGGL(fwd_kernel, dim3(grid), dim3(NTHR), LDS_BYTES, stream, p); }
#else
    p.ph_lo = 0; p.ph_hi = N_PHASES;
    if (hipMemsetAsync((char*)d_ws + WS_BAR, 0, BAR_BYTES, stream) != hipSuccess) { fprintf(stderr, "kernel_launch: memset of barrier words failed\n"); return; }
    void* args[] = {&p};
    hipError_t e = hipLaunchCooperativeKernel((const void*)fwd_kernel, dim3(grid), dim3(NTHR), args, LDS_BYTES, stream);
    if (e != hipSuccess) fprintf(stderr, "cooperative launch failed: %s (grid %d)\n", hipGetErrorString(e), grid);
#endif
}
```

```cpp
#include <hip/hip_runtime.h>
#include <cstdio>
#include <cstdint>
namespace pg8 {
#define PG8_LAS __attribute__((address_space(3)))
typedef unsigned short bf16_t;
typedef short bf16x8 __attribute__((ext_vector_type(8)));
typedef float f32x4 __attribute__((ext_vector_type(4)));
typedef unsigned u32x4 __attribute__((ext_vector_type(4)));
constexpr int BM = 256, BK = 64, HALF = 128, HTB = HALF * BK * 2  , STAGE_BYTES = 8 * HTB, NXCD = 8, WGM = 8;

__host__ __device__ __forceinline__ int lds_byte(int r, int c) { const int st = (r >> 4) * 2 + (c >> 5), rr = r & 15, cc = c & 31, ob = rr * 64 + cc * 2; return st * 1024 + (ob ^ (((ob >> 9) & 1) << 5)); }
__host__ __device__ __forceinline__ void stage_rc(int b, int& R, int& C) { const int st = b / 1024, sb = b % 1024, swz = sb ^ (((sb >> 9) & 1) << 5); R = (st >> 1) * 16 + swz / 64; C = (st & 1) * 32 + (swz % 64) / 2; }
__host__ __device__ __forceinline__ int perm32(int rho) { const int n = rho >> 4, i = rho & 15; return 8 * (i >> 2) + 4 * n + (i & 3); }

struct Unit { int pm, pn; };
struct Gemm { const bf16_t* A; const bf16_t* Bt; int M, N, K; };

struct StaticOrder {
    int nM, nN, nwg, G, c;
    __host__ __device__ void init(int M, int N, int G_, int c_) { nM = M / BM; nN = N / BM; nwg = nM * nN; G = G_; c = c_; }
    __host__ __device__ bool next(int i, Unit& u) const {
        const long L = (long)i * G + c; if (L >= nwg) return false;
        int wgid = (int)L; { const int q = nwg / NXCD, r = nwg % NXCD, xcd = wgid % NXCD, off = wgid / NXCD; wgid = (xcd < r ? xcd * (q + 1) : r * (q + 1) + (xcd - r) * q) + off; }
        const int nig = WGM * nN, gid = wgid / nig, fm = gid * WGM, gsz = (nM - fm) < WGM ? (nM - fm) : WGM;
        u.pm = fm + ((wgid % nig) % gsz); u.pn = (wgid % nig) / gsz; return true;
    }
    __device__ __forceinline__ void a_ready(const Unit&) const {}
    __device__ __forceinline__ void done(const Unit&) const {}
};

typedef float cvt_f32x2_t __attribute__((ext_vector_type(2))); typedef __bf16 cvt_bf16x2_t __attribute__((ext_vector_type(2)));
__device__ __forceinline__ unsigned cvt_pk_bf16(float lo, float hi) { const cvt_f32x2_t v = {lo, hi}; const cvt_bf16x2_t b = __builtin_convertvector(v, cvt_bf16x2_t); return __builtin_bit_cast(unsigned, b); }
typedef float f32x2 __attribute__((ext_vector_type(2)));
__device__ __forceinline__ f32x2 gelu_pk(f32x2 v) {
    const f32x2 av = __builtin_elementwise_abs(v), d = av * 0.2316418882f + 1.0f;
    f32x2 t; t.x = __builtin_amdgcn_rcpf(d.x); t.y = __builtin_amdgcn_rcpf(d.y);
    f32x2 q = t * 0.5307027145f + (-0.7265760135f); q = q * t + 0.7107068705f; q = q * t + (-0.142248368f); q = q * t + 0.127414796f; q = q * t;
    const f32x2 s = (v * v) * (-0.72134752044f);
    f32x2 e; e.x = __builtin_amdgcn_exp2f(s.x); e.y = __builtin_amdgcn_exp2f(s.y);
    const f32x2 m = v * (q * e), r = v - m;
    f32x2 o; o.x = v.x < 0.f ? m.x : r.x; o.y = v.y < 0.f ? m.y : r.y; return o;
}

template <int ACT  > struct EpiBf16 {
    static constexpr bool PERM = true, AFTER_DRAIN = false; static_assert(ACT == 0 || ACT == 1, "EpiBf16: ACT is 0 (none) or 1 (gelu_pk)");
    bf16_t* O; int ldc; const float* bias; int split_cols; size_t split_stride; float scale0;
    __device__ __forceinline__ void operator()(const f32x4 (&acc)[2][2][4][2], const Unit& u, int wr, int wc, int fr, int fq) const {
        const int row0 = u.pm * BM + wr * 64 + fr; int colt = u.pn * BM; bf16_t* base = O;
        float sc = 1.f; if (split_cols) { const int t = colt / split_cols; base += (size_t)t * split_stride; colt -= t * split_cols; if (t == 0) sc = scale0; }
        const int col0 = colt + wc * 32 + 8 * fq, bcol0 = u.pn * BM + wc * 32 + 8 * fq;
        f32x4 bv[2][2];
#pragma unroll
        for (int bj = 0; bj < 2; ++bj)
#pragma unroll
            for (int n = 0; n < 2; ++n) bv[bj][n] = bias ? *(const f32x4*)(bias + bcol0 + bj * HALF + 4 * n) : (f32x4){0.f, 0.f, 0.f, 0.f};
#pragma unroll
        for (int ai = 0; ai < 2; ++ai)
#pragma unroll
            for (int m = 0; m < 4; ++m) { bf16_t* rowp = base + (size_t)(row0 + ai * HALF + m * 16) * ldc + col0;
#pragma unroll
                for (int bj = 0; bj < 2; ++bj) { f32x4 v0 = acc[ai][bj][m][0] + bv[bj][0], v1 = acc[ai][bj][m][1] + bv[bj][1];
                    if (ACT == 1) { f32x2 a = gelu_pk((f32x2){v0[0], v0[1]}), b = gelu_pk((f32x2){v0[2], v0[3]}), c = gelu_pk((f32x2){v1[0], v1[1]}), d = gelu_pk((f32x2){v1[2], v1[3]});
                        v0 = (f32x4){a.x, a.y, b.x, b.y}; v1 = (f32x4){c.x, c.y, d.x, d.y}; }
                    v0 = v0 * sc; v1 = v1 * sc; u32x4 w; w.x = cvt_pk_bf16(v0[0], v0[1]); w.y = cvt_pk_bf16(v0[2], v0[3]); w.z = cvt_pk_bf16(v1[0], v1[1]); w.w = cvt_pk_bf16(v1[2], v1[3]);
                    *(u32x4*)(rowp + bj * HALF) = w; } }
    }
};

__device__ __forceinline__ float sigm(float x) { return __builtin_amdgcn_rcpf(1.0f + __expf(-x)); }
__device__ __forceinline__ float bf2f(unsigned short h) { return __uint_as_float(((unsigned)h) << 16); }
__device__ __forceinline__ u32x4 pack8(f32x4 v0, f32x4 v1) { u32x4 w; w.x = cvt_pk_bf16(v0[0], v0[1]); w.y = cvt_pk_bf16(v0[2], v0[3]); w.z = cvt_pk_bf16(v1[0], v1[1]); w.w = cvt_pk_bf16(v1[2], v1[3]); return w; }
__device__ __forceinline__ void unpack8(u32x4 w, f32x4& v0, f32x4& v1) {
    v0[0] = __uint_as_float(w.x << 16); v0[1] = __uint_as_float(w.x & 0xffff0000u); v0[2] = __uint_as_float(w.y << 16); v0[3] = __uint_as_float(w.y & 0xffff0000u);
    v1[0] = __uint_as_float(w.z << 16); v1[1] = __uint_as_float(w.z & 0xffff0000u); v1[2] = __uint_as_float(w.w << 16); v1[3] = __uint_as_float(w.w & 0xffff0000u); }
__device__ __forceinline__ f32x4 gelu4(f32x4 v) { f32x2 a = gelu_pk((f32x2){v[0], v[1]}), b = gelu_pk((f32x2){v[2], v[3]}); return (f32x4){a.x, a.y, b.x, b.y}; }

struct EpiIn {
    static constexpr bool PERM = true, AFTER_DRAIN = false;
    bf16_t *AU, *AV, *FEAT, *LRAW; const float* rstd; float* lns;
    __device__ __forceinline__ void operator()(f32x4 (&acc)[2][2][4][2], const Unit& u, int wr, int wc, int fr_, int fq_) const {
        int fr = fr_, fq = fq_; asm volatile("" : "+v"(fr), "+v"(fq));
        const int pn = u.pn; bf16_t* base; int ld, ct; bool act;
        if (pn < 4) { base = AU; ld = 1024; ct = pn; act = true; } else if (pn < 8) { base = AV; ld = 1024; ct = pn - 4; act = true; }
        else if (pn < 20) { base = FEAT; ld = 3072; ct = pn - 8; act = false; } else { base = LRAW; ld = 512; ct = pn - 20; act = false; }
        const int row0 = u.pm * BM + wr * 64 + fr, col0 = ct * BM + wc * 32 + 8 * fq;
#pragma unroll
        for (int ai = 0; ai < 2; ++ai)
#pragma unroll
            for (int m = 0; m < 4; ++m) { const int row = row0 + ai * HALF + m * 16; const float rs = rstd[row]; bf16_t* rowp = base + (size_t)row * ld + col0;
                float s1 = 0.f, s2 = 0.f;
#pragma unroll
                for (int bj = 0; bj < 2; ++bj) { f32x4 v0 = acc[ai][bj][m][0] * rs, v1 = acc[ai][bj][m][1] * rs;
                    if (act) { v0 = gelu4(v0); v1 = gelu4(v1); }
                    s1 += ((v0[0] + v0[1]) + (v0[2] + v0[3])) + ((v1[0] + v1[1]) + (v1[2] + v1[3]));
                    s2 += ((v0[0] * v0[0] + v0[1] * v0[1]) + (v0[2] * v0[2] + v0[3] * v0[3])) + ((v1[0] * v1[0] + v1[1] * v1[1]) + (v1[2] * v1[2] + v1[3] * v1[3]));
                    *(u32x4*)(rowp + bj * HALF) = pack8(v0, v1); }
                if (pn >= 4 && pn < 8) { s1 += __shfl_xor(s1, 16); s1 += __shfl_xor(s1, 32); s2 += __shfl_xor(s2, 16); s2 += __shfl_xor(s2, 32);
                    if (fq == 0) { lns[(size_t)row * 32 + (pn - 4) * 4 + wc] = s1; lns[(size_t)row * 32 + 16 + (pn - 4) * 4 + wc] = s2; } } }
    }
};
struct EpiGate {
    static constexpr bool PERM = true, AFTER_DRAIN = false;
    bf16_t* GAB; const float* rstd;
    __device__ __forceinline__ void operator()(f32x4 (&acc)[2][2][4][2], const Unit& u, int wr, int wc, int fr_, int fq_) const {
        int fr = fr_, fq = fq_; asm volatile("" : "+v"(fr), "+v"(fq));
        const int row0 = u.pm * BM + wr * 64 + fr, col0 = u.pn * BM + wc * 32 + 8 * fq;
#pragma unroll
        for (int ai = 0; ai < 2; ++ai)
#pragma unroll
            for (int m = 0; m < 4; ++m) { const int row = row0 + ai * HALF + m * 16; const float rs = rstd[row]; bf16_t* rowp = GAB + (size_t)row * 4096 + col0;
#pragma unroll
                for (int bj = 0; bj < 2; ++bj) { f32x4 v0 = acc[ai][bj][m][0] * rs, v1 = acc[ai][bj][m][1] * rs;
#pragma unroll
                    for (int i = 0; i < 4; ++i) { v0[i] = sigm(v0[i]); v1[i] = sigm(v1[i]); }
                    *(u32x4*)(rowp + bj * HALF) = pack8(v0, v1); } }
    }
};
struct EpiLora {
    static constexpr bool PERM = true, AFTER_DRAIN = false;
    float* DEC; bf16_t* AS; bf16_t* G; const float* w0; const float* a0;
    __device__ __forceinline__ void operator()(f32x4 (&acc)[2][2][4][2], const Unit& u, int wr, int wc, int fr_, int fq_) const {
        int fr = fr_, fq = fq_; asm volatile("" : "+v"(fr), "+v"(fq));
        const int pn = u.pn, kind = pn >> 2, ct = pn & 3;
        const int row0 = u.pm * BM + wr * 64 + fr, col0 = ct * BM + wc * 32 + 8 * fq;
        if (kind == 2) {
#pragma unroll
            for (int ai = 0; ai < 2; ++ai)
#pragma unroll
                for (int m = 0; m < 4; ++m) { bf16_t* rowp = G + (size_t)(row0 + ai * HALF + m * 16) * 1024 + col0;
#pragma unroll
                    for (int bj = 0; bj < 2; ++bj) *(u32x4*)(rowp + bj * HALF) = pack8(acc[ai][bj][m][0], acc[ai][bj][m][1]); }
        } else {
            const float* bias = kind == 0 ? w0 : a0;
#pragma unroll
            for (int bj = 0; bj < 2; ++bj) {
                const f32x4 b0 = *(const f32x4*)(bias + col0 + bj * HALF), b1 = *(const f32x4*)(bias + col0 + bj * HALF + 4);
#pragma unroll
                for (int ai = 0; ai < 2; ++ai)
#pragma unroll
                    for (int m = 0; m < 4; ++m) { const size_t off = (size_t)(row0 + ai * HALF + m * 16) * 1024 + col0 + bj * HALF;
                        f32x4 v0 = acc[ai][bj][m][0] + b0, v1 = acc[ai][bj][m][1] + b1;
                        if (kind == 0) {
#pragma unroll
                            for (int i = 0; i < 4; ++i) { float z = -v0[i]; float sp = fmaxf(z, 0.f) + __logf(1.0f + __expf(-fabsf(z))); v0[i] = __expf(-__expf(-sp - 0.5f));
                                                          z = -v1[i]; sp = fmaxf(z, 0.f) + __logf(1.0f + __expf(-fabsf(z))); v1[i] = __expf(-__expf(-sp - 0.5f)); }
                            *(f32x4*)(DEC + off) = v0; *(f32x4*)(DEC + off + 4) = v1;
                        } else {
#pragma unroll
                            for (int i = 0; i < 4; ++i) { v0[i] = sigm(v0[i]); v1[i] = sigm(v1[i]); }
                            *(u32x4*)(AS + off) = pack8(v0, v1);
                        }
                        }
            }
        }
    }
};
struct EpiPlain {
    static constexpr bool PERM = true, AFTER_DRAIN = false;
    bf16_t* O;
    __device__ __forceinline__ void operator()(f32x4 (&acc)[2][2][4][2], const Unit& u, int wr, int wc, int fr_, int fq_) const {
        int fr = fr_, fq = fq_; asm volatile("" : "+v"(fr), "+v"(fq));
        const int row0 = u.pm * BM + wr * 64 + fr, col0 = u.pn * BM + wc * 32 + 8 * fq;
#pragma unroll
        for (int ai = 0; ai < 2; ++ai)
#pragma unroll
            for (int m = 0; m < 4; ++m) { bf16_t* rowp = O + (size_t)(row0 + ai * HALF + m * 16) * 2048 + col0;
#pragma unroll
                for (int bj = 0; bj < 2; ++bj) *(u32x4*)(rowp + bj * HALF) = pack8(acc[ai][bj][m][0], acc[ai][bj][m][1]); }
    }
};
struct EpiMerge {
    static constexpr bool PERM = true, AFTER_DRAIN = false;
    const bf16_t* GAB; const bf16_t* PA; bf16_t* O;
    __device__ __forceinline__ void operator()(f32x4 (&acc)[2][2][4][2], const Unit& u, int wr, int wc, int fr_, int fq_) const {
        int fr = fr_, fq = fq_; asm volatile("" : "+v"(fr), "+v"(fq));
        const int row0 = u.pm * BM + wr * 64 + fr, col0 = u.pn * BM + wc * 32 + 8 * fq;
#pragma unroll
        for (int ai = 0; ai < 2; ++ai)
#pragma unroll
            for (int m = 0; m < 4; ++m) { const int row = row0 + ai * HALF + m * 16;
#pragma unroll
                for (int bj = 0; bj < 2; ++bj) { const int c = col0 + bj * HALF;
                    f32x4 ga0, ga1, gb0, gb1, p0, p1;
                    unpack8(*(const u32x4*)(GAB + (size_t)row * 4096 + c), ga0, ga1); unpack8(*(const u32x4*)(GAB + (size_t)row * 4096 + 2048 + c), gb0, gb1);
                    unpack8(*(const u32x4*)(PA + (size_t)row * 2048 + c), p0, p1);
                    const f32x4 o0 = ga0 * p0 + gb0 * acc[ai][bj][m][0], o1 = ga1 * p1 + gb1 * acc[ai][bj][m][1];
                    *(u32x4*)(O + (size_t)row * 2048 + c) = pack8(o0, o1); } }
    }
};
template <bool OUTF> struct EpiRes {
    static constexpr bool PERM = true, AFTER_DRAIN = false;
    const bf16_t* base; float* out; bf16_t* ob; float* ssq;
    __device__ __forceinline__ void operator()(f32x4 (&acc)[2][2][4][2], const Unit& u, int wr, int wc, int fr_, int fq_) const {
        int fr = fr_, fq = fq_; asm volatile("" : "+v"(fr), "+v"(fq));
        const int row0 = u.pm * BM + wr * 64 + fr, col0 = u.pn * BM + wc * 32 + 8 * fq;
#pragma unroll
        for (int ai = 0; ai < 2; ++ai)
#pragma unroll
            for (int m = 0; m < 4; ++m) { const int row = row0 + ai * HALF + m * 16; float s = 0.f;
#pragma unroll
                for (int bj = 0; bj < 2; ++bj) { const size_t off = (size_t)row * 2048 + col0 + bj * HALF;
                    f32x4 b0, b1; unpack8(*(const u32x4*)(base + off), b0, b1);
                    const f32x4 x0 = b0 + acc[ai][bj][m][0], x1 = b1 + acc[ai][bj][m][1];
                    if (OUTF) { *(f32x4*)(out + off) = x0; *(f32x4*)(out + off + 4) = x1; }
                    else *(u32x4*)(ob + off) = pack8(x0, x1);
                    s += (x0[0] * x0[0] + x0[1] * x0[1]) + (x0[2] * x0[2] + x0[3] * x0[3]) + (x1[0] * x1[0] + x1[1] * x1[1]) + (x1[2] * x1[2] + x1[3] * x1[3]); }
                s += __shfl_xor(s, 16); s += __shfl_xor(s, 32);
                if (fq == 0) ssq[(size_t)row * 32 + u.pn * 4 + wc] = s; }
    }
};
__device__ __forceinline__ float dpp_ror1(float x) { float r; asm volatile("s_nop 1\n\tv_mov_b32_dpp %0, %1 row_ror:1 row_mask:0xf bank_mask:0xf" : "=&v"(r) : "v"(x)); return r; }
__device__ __forceinline__ float dpp_ror2(float x) { float r; asm volatile("s_nop 1\n\tv_mov_b32_dpp %0, %1 row_ror:2 row_mask:0xf bank_mask:0xf" : "=&v"(r) : "v"(x)); return r; }
struct EpiUp {
    static constexpr bool PERM = true, AFTER_DRAIN = false;
    bf16_t* ACT; const float* ssq1; const float* cw; const float* cb; float* TOP; float* BOT; PG8_LAS unsigned char* el;
    __device__ __forceinline__ void operator()(f32x4 (&acc)[2][2][4][2], const Unit& u, int wr, int wc, int fr_, int fq_) const {
        int fr = fr_, fq = fq_; asm volatile("" : "+v"(fr), "+v"(fq));
        PG8_LAS float* rsL = (PG8_LAS float*)el; PG8_LAS float* hal = (PG8_LAS float*)(el + 1024);
        const int tid = threadIdx.x;
        if (tid < 256) { const f32x4* p = (const f32x4*)(ssq1 + (size_t)(u.pm * BM + tid) * 32); f32x4 s = p[0];
#pragma unroll
            for (int i = 1; i < 8; ++i) s += p[i];
            rsL[tid] = 1.0f / sqrtf(((s[0] + s[1]) + (s[2] + s[3])) * (1.0f / 2048.0f) + 1e-6f); }
        if (fr >= 14) {
#pragma unroll
            for (int ai = 0; ai < 2; ++ai)
#pragma unroll
                for (int bj = 0; bj < 2; ++bj)
#pragma unroll
                    for (int n = 0; n < 2; ++n) *(PG8_LAS f32x4*)(hal + ((2 * ai + wr) * 2 + (fr - 14)) * 256 + bj * HALF + wc * 32 + 8 * fq + 4 * n) = acc[ai][bj][3][n];
        }
        asm volatile("s_waitcnt lgkmcnt(0)" ::: "memory"); __builtin_amdgcn_s_barrier(); asm volatile("" ::: "memory");
        const int jcol = u.pn * HALF + wc * 32 + 8 * fq;
        if (wr == 1 && fr >= 14) { const float rsb = rsL[240 + fr];
#pragma unroll
            for (int bj = 0; bj < 2; ++bj)
#pragma unroll
                for (int n = 0; n < 2; ++n) *(f32x4*)(BOT + ((size_t)u.pm * 2 + (fr - 14)) * 11264 + u.pn * BM + bj * HALF + wc * 32 + 8 * fq + 4 * n) = acc[1][bj][3][n] * rsb; }
#pragma unroll
        for (int ai = 0; ai < 2; ++ai) {
            const int blk = 2 * ai + wr;
            float rsr[4];
#pragma unroll
            for (int m = 0; m < 4; ++m) rsr[m] = rsL[blk * 64 + m * 16 + fr];
            const float rs14 = blk ? rsL[blk * 64 - 2] : 0.f, rs15 = blk ? rsL[blk * 64 - 1] : 0.f;
#pragma unroll
            for (int bj = 0; bj < 2; ++bj)
#pragma unroll
                for (int n = 0; n < 2; ++n) {
                    const int ct = bj * HALF + wc * 32 + 8 * fq + 4 * n;
                    const int cidx = bj * 5632 + jcol + 4 * n;
                    const f32x4 w0 = *(const f32x4*)(cw + cidx), w1 = *(const f32x4*)(cw + 11264 + cidx), w2 = *(const f32x4*)(cw + 22528 + cidx), b4 = *(const f32x4*)(cb + cidx);
                    f32x4 pR1 = (f32x4){0.f, 0.f, 0.f, 0.f}, pR2 = pR1;
                    if (blk) { const f32x4 h14 = *(const PG8_LAS f32x4*)(hal + ((blk - 1) * 2 + 0) * 256 + ct) * rs14, h15 = *(const PG8_LAS f32x4*)(hal + ((blk - 1) * 2 + 1) * 256 + ct) * rs15;
                        pR1 = h15; pR2 = (fr == 0) ? h14 : h15; }
#pragma unroll
                    for (int m = 0; m < 4; ++m) {
                        const f32x4 U = acc[ai][bj][m][n] * rsr[m];
                        f32x4 R1, R2;
#pragma unroll
                        for (int i = 0; i < 4; ++i) { R1[i] = dpp_ror1(U[i]); R2[i] = dpp_ror2(U[i]); }
                        const f32x4 U1 = (fr >= 1) ? R1 : pR1, U2 = (fr >= 2) ? R2 : pR2;
                        const f32x4 C = b4 + w0 * U2 + w1 * U1 + w2 * U;
                        acc[ai][bj][m][n] = C; pR1 = R1; pR2 = R2;
                        asm volatile("" : "+v"(acc[ai][bj][m][n]));
                    }

                }
            if (ai == 0 && wr == 0 && fr < 2) {
#pragma unroll
                for (int bj = 0; bj < 2; ++bj)
#pragma unroll
                    for (int n = 0; n < 2; ++n) *(f32x4*)(TOP + ((size_t)u.pm * 2 + fr) * 11264 + u.pn * BM + bj * HALF + wc * 32 + 8 * fq + 4 * n) = acc[0][bj][0][n]; }
#pragma unroll
            for (int m = 0; m < 4; ++m) { const int row = u.pm * BM + blk * 64 + m * 16 + fr;
                const f32x4 g0 = gelu4(acc[ai][0][m][0]), g1 = gelu4(acc[ai][0][m][1]);
                *(u32x4*)(ACT + (size_t)row * 5632 + jcol) = pack8(g0 * acc[ai][1][m][0], g1 * acc[ai][1][m][1]); }
        }
    }
};
template <class Epi, class Sched, bool ALIGN_EPI = false, bool SP2 = false>
__device__ __forceinline__ void gemm_phase(PG8_LAS unsigned char* lds, const Gemm g, const Sched& S, const Epi& E) {
    const int tid = threadIdx.x, wid = __builtin_amdgcn_readfirstlane(tid >> 6), lane = tid & 63, wr = wid >> 2, wc = wid & 3, fr = lane & 15, fq = lane >> 4;
    const int K = g.K, nt = K / BK;
    unsigned voffA[2], voffB[2];
#pragma unroll
    for (int i = 0; i < 2; ++i) { int R, C; stage_rc(tid * 16 + i * 8192, R, C); const int Rb = Epi::PERM ? ((R & ~31) + perm32(R & 31)) : R;
        voffA[i] = (unsigned)(R * K + C) * 2u; voffB[i] = (unsigned)(Rb * K + C) * 2u; }
    const size_t kstep = (size_t)(BK * 2);
    const size_t hstep = (size_t)HALF * K * 2;
    const size_t tstep = 2 * hstep;
    const unsigned ldsw = (unsigned)wid * 1024u;
    const int aoff = lds_byte(wr * 64 + fr, fq * 8), boff = lds_byte(wc * 32 + fr, fq * 8);
#define PG8_SA(b, h) (((b) * 2 + (h)) * HTB)
#define PG8_SB(b, h) ((4 + (b) * 2 + (h)) * HTB)
#define PG8_STAGE(bufoff, gbase, voff) do { _Pragma("unroll") for (int _i = 0; _i < 2; ++_i) \
        __builtin_amdgcn_global_load_lds((const unsigned*)((const char*)(gbase) + (voff)[_i]), (PG8_LAS unsigned*)(lds + (bufoff) + ldsw + _i * 8192), 16, 0, 0); } while (0)
#define PG8_LDA(dst, b, h) do { _Pragma("unroll") for (int m = 0; m < 4; ++m) _Pragma("unroll") for (int k = 0; k < 2; ++k) dst[m][k] = *(const PG8_LAS bf16x8*)(lds + PG8_SA(b, h) + aoff + m * 2048 + k * 1024); } while (0)
#define PG8_LDB(dst, b, h) do { _Pragma("unroll") for (int n = 0; n < 2; ++n) _Pragma("unroll") for (int k = 0; k < 2; ++k) dst[n][k] = *(const PG8_LAS bf16x8*)(lds + PG8_SB(b, h) + boff + n * 2048 + k * 1024); } while (0)
#define PG8_MMA(ai, bj, At, Bt) do { __builtin_amdgcn_s_setprio(1); _Pragma("unroll") for (int m = 0; m < 4; ++m) _Pragma("unroll") for (int n = 0; n < 2; ++n) _Pragma("unroll") for (int k = 0; k < 2; ++k) \
        acc[ai][bj][m][n] = __builtin_amdgcn_mfma_f32_16x16x32_bf16(Bt[n][k], At[m][k], acc[ai][bj][m][n], 0, 0, 0); __builtin_amdgcn_s_setprio(0); } while (0)
#define PG8_WAIT_V(n) asm volatile("s_waitcnt vmcnt(" #n ")" ::: "memory")
#define PG8_WAIT_L(n) asm volatile("s_waitcnt lgkmcnt(" #n ")" ::: "memory")
#define PG8_BAR __builtin_amdgcn_s_barrier()
#define PG8_SCHED __builtin_amdgcn_sched_barrier(0)
    Unit cur, nxt; int ui = 0;
    if (!S.next(0, cur)) return;
    f32x4 acc[2][2][4][2];
#pragma unroll
    for (int a = 0; a < 2; ++a)
#pragma unroll
        for (int b = 0; b < 2; ++b)
#pragma unroll
            for (int m = 0; m < 4; ++m)
#pragma unroll
                for (int n = 0; n < 2; ++n) acc[a][b][m][n] = (f32x4){0.f, 0.f, 0.f, 0.f};
    bf16x8 At[4][2], B0[2][2], B1[2][2];
    const char* cA = (const char*)g.A + (size_t)cur.pm * tstep; const char* cB = (const char*)g.Bt + (size_t)cur.pn * tstep;
    S.a_ready(cur);
    if constexpr (SP2) {
        PG8_STAGE(PG8_SB(0, 0), cB, voffB); PG8_STAGE(PG8_SB(0, 1), cB + hstep, voffB); PG8_STAGE(PG8_SA(0, 0), cA, voffA); PG8_STAGE(PG8_SA(0, 1), cA + hstep, voffA);
        if (wr == 1) PG8_BAR;
        PG8_WAIT_V(2); PG8_BAR;
        PG8_STAGE(PG8_SB(1, 0), cB + kstep, voffB); PG8_STAGE(PG8_SA(1, 0), cA + kstep, voffA); PG8_STAGE(PG8_SB(1, 1), cB + hstep + kstep, voffB);
        PG8_WAIT_V(6); PG8_BAR;
    } else {
        PG8_STAGE(PG8_SB(0, 0), cB, voffB); PG8_STAGE(PG8_SA(0, 0), cA, voffA); PG8_STAGE(PG8_SB(0, 1), cB + hstep, voffB); PG8_STAGE(PG8_SA(0, 1), cA + hstep, voffA);
        if (wr == 1) PG8_BAR;
        PG8_WAIT_V(4); PG8_BAR;
        PG8_STAGE(PG8_SB(1, 0), cB + kstep, voffB); PG8_STAGE(PG8_SA(1, 0), cA + kstep, voffA); PG8_STAGE(PG8_SB(1, 1), cB + hstep + kstep, voffB);
        PG8_WAIT_V(6); PG8_BAR;
    }
    for (;;) {
        const bool has_next = S.next(ui + 1, nxt);
        const char* nA = has_next ? (const char*)g.A + (size_t)nxt.pm * tstep : cA; const char* nB = has_next ? (const char*)g.Bt + (size_t)nxt.pn * tstep : cB;
        for (int t = 0; t < nt; t += 2) {
            const bool last = (t == nt - 2);
            const char* a1 = cA + (size_t)(t + 1) * kstep;
            const char* a2 = last ? nA : cA + (size_t)(t + 2) * kstep; const char* b2 = last ? nB : cB + (size_t)(t + 2) * kstep;
            const char* a3 = a2 + kstep; const char* b3 = b2 + kstep;
            if (last && has_next) S.a_ready(nxt);
            if constexpr (SP2) {
            PG8_LDB(B0, 0, 0); PG8_LDB(B1, 0, 1); PG8_SCHED; PG8_LDA(At, 0, 0); PG8_STAGE(PG8_SA(1, 1), a1 + hstep, voffA);
            PG8_WAIT_V(8); PG8_WAIT_L(0); PG8_BAR; PG8_MMA(0, 0, At, B0); PG8_MMA(0, 1, At, B1); PG8_BAR; PG8_SCHED;
            PG8_LDA(At, 0, 1); PG8_STAGE(PG8_SB(0, 0), b2, voffB); PG8_STAGE(PG8_SB(0, 1), b2 + hstep, voffB); PG8_STAGE(PG8_SA(0, 0), a2, voffA);
            PG8_WAIT_V(8); PG8_WAIT_L(0); PG8_BAR; PG8_MMA(1, 0, At, B0); PG8_MMA(1, 1, At, B1); PG8_BAR; PG8_SCHED;
            PG8_LDB(B0, 1, 0); PG8_LDB(B1, 1, 1); PG8_SCHED; PG8_LDA(At, 1, 0); PG8_STAGE(PG8_SA(0, 1), a2 + hstep, voffA);
            PG8_WAIT_V(8); PG8_WAIT_L(0); PG8_BAR; PG8_MMA(0, 0, At, B0); PG8_MMA(0, 1, At, B1); PG8_BAR; PG8_SCHED;
            PG8_LDA(At, 1, 1); PG8_STAGE(PG8_SB(1, 0), b3, voffB); PG8_STAGE(PG8_SB(1, 1), b3 + hstep, voffB); PG8_STAGE(PG8_SA(1, 0), a3, voffA);
            PG8_WAIT_V(8); PG8_WAIT_L(0); PG8_BAR; PG8_MMA(1, 0, At, B0); PG8_MMA(1, 1, At, B1); PG8_BAR; PG8_SCHED;
            } else {
            PG8_LDB(B0, 0, 0); PG8_SCHED; PG8_LDA(At, 0, 0); PG8_STAGE(PG8_SA(1, 1), a1 + hstep, voffA);
            PG8_WAIT_L(8); PG8_BAR; PG8_WAIT_L(0); PG8_MMA(0, 0, At, B0); PG8_BAR; PG8_SCHED;
            PG8_LDB(B1, 0, 1); PG8_STAGE(PG8_SB(0, 0), b2, voffB);
            PG8_BAR; PG8_WAIT_L(0); PG8_MMA(0, 1, At, B1); PG8_BAR;
            PG8_LDA(At, 0, 1); PG8_STAGE(PG8_SA(0, 0), a2, voffA);
            PG8_BAR; PG8_WAIT_L(0); PG8_MMA(1, 0, At, B0); PG8_BAR; PG8_SCHED;
            PG8_STAGE(PG8_SB(0, 1), b2 + hstep, voffB);
            PG8_WAIT_V(6); PG8_BAR; PG8_MMA(1, 1, At, B1); PG8_BAR;
            PG8_LDB(B0, 1, 0); PG8_SCHED; PG8_LDA(At, 1, 0); PG8_STAGE(PG8_SA(0, 1), a2 + hstep, voffA);
            PG8_WAIT_L(8); PG8_BAR; PG8_WAIT_L(0); PG8_MMA(0, 0, At, B0); PG8_BAR; PG8_SCHED;
            PG8_LDB(B1, 1, 1); PG8_STAGE(PG8_SB(1, 0), b3, voffB);
            PG8_BAR; PG8_WAIT_L(0); PG8_MMA(0, 1, At, B1); PG8_BAR;
            PG8_LDA(At, 1, 1); PG8_STAGE(PG8_SA(1, 0), a3, voffA);
            PG8_BAR; PG8_WAIT_L(0); PG8_MMA(1, 0, At, B0); PG8_BAR; PG8_SCHED;
            PG8_STAGE(PG8_SB(1, 1), b3 + hstep, voffB);
            PG8_WAIT_V(6); PG8_BAR; PG8_MMA(1, 1, At, B1); PG8_BAR;
            }
        }
        if constexpr (ALIGN_EPI) { if (wr == 0) PG8_BAR; }
        if constexpr (!Epi::AFTER_DRAIN) { E(acc, cur, wr, wc, fr, fq); S.done(cur); }
        if (!has_next) break;
#pragma unroll
        for (int a = 0; a < 2; ++a)
#pragma unroll
            for (int b = 0; b < 2; ++b)
#pragma unroll
                for (int m = 0; m < 4; ++m)
#pragma unroll
                    for (int n = 0; n < 2; ++n) acc[a][b][m][n] = (f32x4){0.f, 0.f, 0.f, 0.f};
        cur = nxt; cA = nA; cB = nB; ++ui;
        if constexpr (ALIGN_EPI) { if (wr == 1) PG8_BAR; }
    }
    PG8_WAIT_V(0);
    if constexpr (!ALIGN_EPI) { if (wr == 0) PG8_BAR; }
    PG8_BAR;
    if constexpr (Epi::AFTER_DRAIN) { E.fused(acc, cur, wr, wc, fr, fq, lds, wid, lane); S.done(cur); }
#undef PG8_SA
#undef PG8_SB
#undef PG8_STAGE
#undef PG8_LDA
#undef PG8_LDB
#undef PG8_MMA
#undef PG8_WAIT_V
#undef PG8_WAIT_L
#undef PG8_BAR
#undef PG8_SCHED
}
}

#include <hip/hip_cooperative_groups.h>
namespace cg = cooperative_groups;
#define LAS __attribute__((address_space(3)))
typedef unsigned short bf16;
typedef float f32x4 __attribute__((ext_vector_type(4)));
typedef float f32x2 __attribute__((ext_vector_type(2)));
typedef short bf16x8 __attribute__((ext_vector_type(8)));
typedef unsigned u32x4 __attribute__((ext_vector_type(4)));
typedef unsigned u32x2 __attribute__((ext_vector_type(2)));

constexpr int T = 32768, SEQ = 16384, DM = 2048, DA = 1024, DB = 1024, NH = 16, DFF = 5632;
constexpr int N_IN1 = 5632, N_GATE = 4096, N_LORA = 3072, K_LORA = 384;
constexpr int NCH = 64, CL = SEQ / NCH;
constexpr int NWAVES = 8, NTHR = 512;
constexpr int LDS_BYTES = 147456, EPI_OFF = 131072 + 1024;
constexpr size_t MiB = 1u << 20;
constexpr size_t WS_W_IN = 0, WS_W_LORA = 38 * MiB, WS_W_PA = 41 * MiB, WS_W_PB = 45 * MiB, WS_W_OUT = 49 * MiB, WS_W_UP = 57 * MiB, WS_W_DOWN = 101 * MiB;
constexpr size_t WS_BAR = 135 * MiB, BAR_BYTES = 16384;
constexpr size_t WS_RSTD1 = 124 * MiB, WS_SSQ1 = 125 * MiB, WS_SSQ2 = 129 * MiB, WS_BONUS = 133 * MiB;
constexpr size_t WS_XB = 136 * MiB;
constexpr size_t WS_AU = 264 * MiB, WS_AV = 328 * MiB;
constexpr size_t WS_DEC = WS_AU, WS_MERGED = WS_AU;
constexpr size_t WS_FEAT = 392 * MiB;
constexpr size_t WS_PA = WS_FEAT, WS_ACT = WS_FEAT;
constexpr size_t WS_LRAW = 584 * MiB, WS_LIN = 616 * MiB;
constexpr size_t WS_AS = 640 * MiB, WS_ST = 896 * MiB;
constexpr size_t WS_G = 704 * MiB, WS_YA = 768 * MiB, WS_YB = 832 * MiB, WS_B = 896 * MiB;
constexpr size_t WS_TOP = 960 * MiB, WS_BOT = 971 * MiB, WS_END = 982 * MiB;

struct Params {
    const float* in[27]; float* out; unsigned char* ws; int ph_lo, ph_hi;
};
enum { I_X = 0, I_N1G, I_WIN, I_MU, I_W0, I_W2, I_A0, I_A2, I_G2, I_KK, I_KA, I_RK, I_LNW, I_LNB, I_GLNW, I_GLNB, I_GWS, I_GBS, I_WPA, I_WPB, I_WOUT, I_N2G, I_WUP, I_CW, I_CB, I_WDOWN, I_NFG };

__device__ __forceinline__ float bf2f(unsigned short h) { return __uint_as_float(((unsigned)h) << 16); }
__device__ __forceinline__ unsigned pk2(float lo, float hi);
__device__ __forceinline__ unsigned f2bf(float f) { return pk2(f, 0.f) & 0xffffu; }
__device__ __forceinline__ unsigned pk2(float lo, float hi) { return pg8::cvt_pk_bf16(lo, hi); }
__device__ __forceinline__ float wave_sum(float v) {
#pragma unroll
    for (int o = 1; o < 64; o <<= 1) v += __shfl_xor(v, o);
    return v;
}
__device__ __forceinline__ float dpp_shr_z(float v, int ctrl_sel) {
    const int iv = __float_as_int(v); int r;
    switch (ctrl_sel) { case 1: r = __builtin_amdgcn_update_dpp(0, iv, 0x111, 0xf, 0xf, true); break; case 2: r = __builtin_amdgcn_update_dpp(0, iv, 0x112, 0xf, 0xf, true); break;
                        case 4: r = __builtin_amdgcn_update_dpp(0, iv, 0x114, 0xf, 0xf, true); break; default: r = __builtin_amdgcn_update_dpp(0, iv, 0x118, 0xf, 0xf, true); break; }
    return __int_as_float(r);
}
__device__ __forceinline__ void wave_sum2(float& a, float& b) {
    a += dpp_shr_z(a, 1); b += dpp_shr_z(b, 1); a += dpp_shr_z(a, 2); b += dpp_shr_z(b, 2); a += dpp_shr_z(a, 4); b += dpp_shr_z(b, 4); a += dpp_shr_z(a, 8); b += dpp_shr_z(b, 8);
    a += __int_as_float(__builtin_amdgcn_update_dpp(0, __float_as_int(a), 0x142, 0xa, 0xf, false)); b += __int_as_float(__builtin_amdgcn_update_dpp(0, __float_as_int(b), 0x142, 0xa, 0xf, false));
    a += __int_as_float(__builtin_amdgcn_update_dpp(0, __float_as_int(a), 0x143, 0xc, 0xf, false)); b += __int_as_float(__builtin_amdgcn_update_dpp(0, __float_as_int(b), 0x143, 0xc, 0xf, false));
    a = __int_as_float(__builtin_amdgcn_readlane(__float_as_int(a), 63)); b = __int_as_float(__builtin_amdgcn_readlane(__float_as_int(b), 63));
}
__device__ __forceinline__ float gelu_f(float x) { return 0.5f * x * (1.0f + erff(x * 0.70710678118654752f)); }
#define LDS_WAIT() asm volatile("s_waitcnt lgkmcnt(0)" ::: "memory")
#define RLF(v, k) __int_as_float(__builtin_amdgcn_readlane(__float_as_int(v), k))
#define DPPX(v, ctrl) __int_as_float(__builtin_amdgcn_update_dpp(0, __float_as_int(v), ctrl, 0xf, 0xf, false))
__device__ __forceinline__ float sum8(float v) { v += DPPX(v, 0xB1); v += DPPX(v, 0x4E); v += DPPX(v, 0x141); return v; }
__device__ __forceinline__ void ld8(const bf16* p, float (&o)[8]) { const u32x4 w = *(const u32x4*)p;
    o[0] = __uint_as_float(w.x << 16); o[1] = __uint_as_float(w.x & 0xffff0000u); o[2] = __uint_as_float(w.y << 16); o[3] = __uint_as_float(w.y & 0xffff0000u);
    o[4] = __uint_as_float(w.z << 16); o[5] = __uint_as_float(w.z & 0xffff0000u); o[6] = __uint_as_float(w.w << 16); o[7] = __uint_as_float(w.w & 0xffff0000u); }
__device__ __forceinline__ void st8(bf16* p, const float (&v)[8]) { u32x4 w; w.x = pk2(v[0], v[1]); w.y = pk2(v[2], v[3]); w.z = pk2(v[4], v[5]); w.w = pk2(v[6], v[7]); *(u32x4*)p = w; }
__device__ __forceinline__ void st8nt(bf16* p, const float (&v)[8]) { u32x4 w; w.x = pk2(v[0], v[1]); w.y = pk2(v[2], v[3]); w.z = pk2(v[4], v[5]); w.w = pk2(v[6], v[7]); __builtin_nontemporal_store(w, (u32x4*)p); }
__device__ __forceinline__ void ldf8(const float* p, float (&o)[8]) { const f32x4 a = *(const f32x4*)p, b = *(const f32x4*)(p + 4); o[0] = a[0]; o[1] = a[1]; o[2] = a[2]; o[3] = a[3]; o[4] = b[0]; o[5] = b[1]; o[6] = b[2]; o[7] = b[3]; }

__device__ __forceinline__ void tr_item(const float* W, int ldw, int srccol, int k0, const float* kscale, bf16* WT, int K, int drow0, LAS float* scr, int lane) {
    float v[64];
#pragma unroll
    for (int kk = 0; kk < 64; ++kk) v[kk] = (srccol >= 0) ? W[(size_t)(k0 + kk) * ldw + srccol] : 0.f;
    if (kscale) {
#pragma unroll
        for (int kk = 0; kk < 64; kk += 4) { const f32x4 s4 = *(const f32x4*)(kscale + k0 + kk); v[kk] *= s4[0]; v[kk + 1] *= s4[1]; v[kk + 2] *= s4[2]; v[kk + 3] *= s4[3]; } }
#pragma unroll
    for (int kk = 0; kk < 64; ++kk) scr[kk * 65 + lane] = v[kk];
    LDS_WAIT(); asm volatile("" ::: "memory");
    const int c = lane & 7;
#pragma unroll
    for (int j = 0; j < 8; ++j) { const int n = (lane >> 3) + 8 * j; const LAS float* s = scr + (8 * c) * 65 + n;
        u32x4 o; o.x = pk2(s[0 * 65], s[1 * 65]); o.y = pk2(s[2 * 65], s[3 * 65]); o.z = pk2(s[4 * 65], s[5 * 65]); o.w = pk2(s[6 * 65], s[7 * 65]);
        *(u32x4*)(WT + (size_t)(drow0 + n) * K + k0 + 8 * c) = o; }
    LDS_WAIT(); asm volatile("" ::: "memory");
}
template <int PART> __device__ __forceinline__ void convert_weights(const Params& p, LAS unsigned char* lds, int gw, int NGW) {
    const int lane = threadIdx.x & 63, wave = threadIdx.x >> 6;
    LAS float* scr = (LAS float*)(lds + wave * 16640);
    unsigned char* ws = p.ws;
    constexpr int I1 = 32 * 152, I2 = 16 * 32, I3 = 16 * 32, I4 = 32 * 32, I5 = 32 * 176, I6 = 88 * 32;
    if (PART == 0) {
        for (int r = gw; r < I1; r += NGW) { const int kb = r / 152, nb = r % 152, n0 = nb * 64, n = n0 + lane; const int src = n < 5408 ? n : (n < 5632 ? -1 : n - 224);
            tr_item(p.in[I_WIN], 9504, src, kb * 64, p.in[I_N1G], (bf16*)(ws + WS_W_IN), 2048, n0, scr, lane); }
    } else {
        for (int it = gw; it < I2 + I3 + I4 + I5 + I6; it += NGW) {
            int r = it;
            if (r < I2) { const int kb = r / 32, nb = r % 32; tr_item(p.in[I_WPA], 2048, nb * 64 + lane, kb * 64, nullptr, (bf16*)(ws + WS_W_PA), 1024, nb * 64, scr, lane); continue; } r -= I2;
            if (r < I3) { const int kb = r / 32, nb = r % 32; tr_item(p.in[I_WPB], 2048, nb * 64 + lane, kb * 64, nullptr, (bf16*)(ws + WS_W_PB), 1024, nb * 64, scr, lane); continue; } r -= I3;
            if (r < I4) { const int kb = r / 32, nb = r % 32; tr_item(p.in[I_WOUT], 2048, nb * 64 + lane, kb * 64, nullptr, (bf16*)(ws + WS_W_OUT), 2048, nb * 64, scr, lane); continue; } r -= I4;
            if (r < I5) { const int kb = r / 176, nb = r % 176, n0 = nb * 64, n = n0 + lane, j = n >> 8, w = n & 255; const int src = w < 128 ? 128 * j + w : 5632 + 128 * j + (w - 128);
                tr_item(p.in[I_WUP], 11264, src, kb * 64, p.in[I_N2G], (bf16*)(ws + WS_W_UP), 2048, n0, scr, lane); continue; } r -= I5;
            { const int kb = r / 32, nb = r % 32; tr_item(p.in[I_WDOWN], 2048, nb * 64 + lane, kb * 64, nullptr, (bf16*)(ws + WS_W_DOWN), 5632, nb * 64, scr, lane); }
        }
    }
}
__device__ __forceinline__ void phase_prologue(const Params& p, LAS unsigned char* lds) {
    const int tid = threadIdx.x, lane = tid & 63, wave = tid >> 6, G = gridDim.x;
    const int gw = blockIdx.x * NWAVES + wave, NGW = G * NWAVES;
    unsigned char* ws = p.ws;
    convert_weights<0>(p, lds, gw, NGW);
    if (G <= 128) convert_weights<1>(p, lds, gw, NGW);
    { bf16* WL = (bf16*)(ws + WS_W_LORA); const int gt = blockIdx.x * NTHR + tid, NGT = G * NTHR;
      for (int i = gt; i < N_LORA * K_LORA; i += NGT) { const int n = i / K_LORA, k = i % K_LORA; float v = 0.f;
          if (n < 1024) { if (k < 64) v = p.in[I_W2][k * 1024 + n]; }
          else if (n < 2048) { if (k >= 64 && k < 128) v = p.in[I_A2][(k - 64) * 1024 + (n - 1024)]; }
          else { if (k >= 128 && k < 288) v = p.in[I_G2][(k - 128) * 1024 + (n - 2048)]; }
          WL[i] = (bf16)f2bf(v); } }
    { const float* x = p.in[I_X]; bf16* xb = (bf16*)(ws + WS_XB); float* rstd = (float*)(ws + WS_RSTD1);
      constexpr int UR = 4;
      for (int row0 = gw; row0 < T; row0 += UR * NGW) { f32x4 v[UR][8]; float s[UR];
#pragma unroll
          for (int u = 0; u < UR; ++u) { const f32x4* xr = (const f32x4*)(x + (size_t)(row0 + u * NGW) * DM) + lane;
#pragma unroll
              for (int j = 0; j < 8; ++j) v[u][j] = __builtin_nontemporal_load(xr + 64 * j); }
#pragma unroll
          for (int u = 0; u < UR; ++u) { const int row = row0 + u * NGW; s[u] = 0.f;
#pragma unroll
              for (int j = 0; j < 8; ++j) s[u] += (v[u][j][0] * v[u][j][0] + v[u][j][1] * v[u][j][1]) + (v[u][j][2] * v[u][j][2] + v[u][j][3] * v[u][j][3]);
              s[u] = wave_sum(s[u]); if (lane == 0) rstd[row] = 1.0f / sqrtf(s[u] * (1.0f / DM) + 1e-6f);
              u32x2* o = (u32x2*)(xb + (size_t)row * DM) + lane;
#pragma unroll
              for (int j = 0; j < 8; ++j) { u32x2 w; w.x = pk2(v[u][j][0], v[u][j][1]); w.y = pk2(v[u][j][2], v[u][j][3]); o[64 * j] = w; } } } }
}

__device__ __forceinline__ void phase_gmlp(const Params& p, LAS unsigned char* lds) {
    const int tid = threadIdx.x, lane = tid & 63, wave = tid >> 6, G = gridDim.x;
    unsigned char* ws = p.ws;
    const bf16* AU = (const bf16*)(ws + WS_AU); const bf16* AV = (const bf16*)(ws + WS_AV); bf16* YA = (bf16*)(ws + WS_YA);
    const float* LNS = (const float*)(ws + WS_SSQ2);
    LAS bf16* WM = (LAS bf16*)lds;
    LAS bf16* VT = (LAS bf16*)(lds + 34816);
    LAS float* st = (LAS float*)(lds + 69632);
    const int g = blockIdx.x & 7, nb = G >> 3;
    if ((int)blockIdx.x < nb * 8) {
        __syncthreads();
        { const float* wg = p.in[I_GWS] + (size_t)g * 16384;
#pragma unroll
          for (int j = 0; j < 8; ++j) { const int e = tid + 512 * j, t = e >> 5, s4 = (e & 31) * 4; f32x4 w = *(const f32x4*)(wg + t * 128 + s4);
#pragma unroll
              for (int i = 0; i < 4; ++i) if (s4 + i > t) w[i] = 0.f;
              u32x2 o; o.x = pk2(w[0], w[1]); o.y = pk2(w[2], w[3]); *(LAS u32x2*)(WM + t * 136 + s4) = o; } }
        const int c8 = (tid & 15) * 8;
        float lw8[8], lb8[8]; ldf8(p.in[I_GLNW] + g * 128 + c8, lw8); ldf8(p.in[I_GLNB] + g * 128 + c8, lb8);
        const float* bsg = p.in[I_GBS] + g * 128;
        u32x4 avn[4];
        { const int ch0 = blockIdx.x >> 3;
#pragma unroll
          for (int i = 0; i < 4; ++i) { const int s = (tid >> 4) + 32 * i; avn[i] = (ch0 < T / 128) ? *(const u32x4*)(AV + (size_t)(ch0 * 128 + s) * DA + g * 128 + c8) : (u32x4){0u, 0u, 0u, 0u}; } }
        for (int ch = blockIdx.x >> 3; ch < T / 128; ch += nb) {
            const int t0 = ch * 128;
            float av[4][8];
#pragma unroll
            for (int i = 0; i < 4; ++i) { f32x4 x0, x1; pg8::unpack8(avn[i], x0, x1); av[i][0] = x0[0]; av[i][1] = x0[1]; av[i][2] = x0[2]; av[i][3] = x0[3]; av[i][4] = x1[0]; av[i][5] = x1[1]; av[i][6] = x1[2]; av[i][7] = x1[3]; }
            if (tid < 128) { const f32x4* q = (const f32x4*)(LNS + (size_t)(t0 + tid) * 32); f32x4 a = q[0] + q[1] + q[2] + q[3], b = q[4] + q[5] + q[6] + q[7];
                const float mean = ((a[0] + a[1]) + (a[2] + a[3])) * (1.0f / DA), ex2 = ((b[0] + b[1]) + (b[2] + b[3])) * (1.0f / DA);
                st[tid] = mean; st[128 + tid] = 1.0f / sqrtf(fmaxf(ex2 - mean * mean, 0.f) + 1e-5f); }
            __syncthreads();
#pragma unroll
            for (int i = 0; i < 4; ++i) { const int s = (tid >> 4) + 32 * i; const float mean = st[s], rs = st[128 + s];
#pragma unroll
                for (int j = 0; j < 8; ++j) VT[(c8 + j) * 136 + ((((s >> 3) ^ (tid & 15)) << 3) | (s & 7))] = (bf16)f2bf((av[i][j] - mean) * rs * lw8[j] + lb8[j]); }
            __syncthreads();
            if (ch + nb < T / 128) {
#pragma unroll
                for (int i = 0; i < 4; ++i) { const int s = (tid >> 4) + 32 * i; avn[i] = *(const u32x4*)(AV + (size_t)((ch + nb) * 128 + s) * DA + g * 128 + c8); } }
            const size_t rowo = (size_t)(t0 + 16 * wave + (lane & 15)) * DA + g * 128 + 4 * (lane >> 4);
            u32x2 aur[8];
#pragma unroll
            for (int ct = 0; ct < 8; ++ct) aur[ct] = *(const u32x2*)(AU + rowo + 16 * ct);
            f32x4 acc[8];
#pragma unroll
            for (int ct = 0; ct < 8; ++ct) acc[ct] = (f32x4){0.f, 0.f, 0.f, 0.f};
            const int nk = (16 * wave + 15) / 32 + 1;
            for (int ks = 0; ks < nk; ++ks) { const bf16x8 wmf = *(const LAS bf16x8*)(WM + (16 * wave + (lane & 15)) * 136 + ks * 32 + 8 * (lane >> 4));
#pragma unroll
                for (int ct = 0; ct < 8; ++ct) { const bf16x8 vtf = *(const LAS bf16x8*)(VT + (16 * ct + (lane & 15)) * 136 + (((ks * 4 + (lane >> 4)) ^ (2 * ct + ((lane & 15) >> 3))) << 3));
                    acc[ct] = __builtin_amdgcn_mfma_f32_16x16x32_bf16(vtf, wmf, acc[ct], 0, 0, 0); } }
            { const float bsv = bsg[16 * wave + (lane & 15)];
#pragma unroll
              for (int ct = 0; ct < 8; ++ct) { const u32x2 aw = aur[ct];
                  const float o0 = (acc[ct][0] + bsv) * __uint_as_float(aw.x << 16), o1 = (acc[ct][1] + bsv) * __uint_as_float(aw.x & 0xffff0000u);
                  const float o2 = (acc[ct][2] + bsv) * __uint_as_float(aw.y << 16), o3 = (acc[ct][3] + bsv) * __uint_as_float(aw.y & 0xffff0000u);
                  u32x2 w; w.x = pk2(o0, o1); w.y = pk2(o2, o3); *(u32x2*)(YA + rowo + 16 * ct) = w; } }
        }
    }
    { const bf16* LRAW = (const bf16*)(ws + WS_LRAW); bf16* LIN = (bf16*)(ws + WS_LIN); const float* mu = p.in[I_MU];
      const int gt = blockIdx.x * NTHR + tid, NGT = G * NTHR;
      for (int i0 = gt; i0 < T * 48; i0 += 4 * NGT) { float cur[4][8], prev[4][8];
#pragma unroll
          for (int u = 0; u < 4; ++u) { const int i = i0 + u * NGT; if (i < T * 48) { const int t = i / 48, c = (i % 48) * 8;
              if (c < 288) { ld8(LRAW + (size_t)t * 512 + c, cur[u]); ld8(LRAW + (size_t)((t % SEQ) ? t - 1 : t) * 512 + c, prev[u]); } } }
#pragma unroll
          for (int u = 0; u < 4; ++u) { const int i = i0 + u * NGT; if (i < T * 48) { const int t = i / 48, c = (i % 48) * 8; float o[8];
              if (c < 288) { float m8[8]; ldf8(mu + 3072 + c, m8); const bool first = (t % SEQ) == 0;
#pragma unroll
                  for (int j = 0; j < 8; ++j) { const float pv = first ? 0.f : prev[u][j]; const float m = cur[u][j] + (pv - cur[u][j]) * m8[j];
                      o[j] = c < 64 ? tanhf(m) : (c < 128 ? m : 1.0f / (1.0f + __expf(-m))); } }
              else {
#pragma unroll
                  for (int j = 0; j < 8; ++j) o[j] = 0.f; }
              st8(LIN + (size_t)t * K_LORA + c, o); } } } }
}

#define SCAN_FENCE(j)
template <bool PASS2> struct ScanCfg { static constexpr int SB = 4; };
template <bool PASS2, int MODE = 0> __device__ __forceinline__ void phase_scan(const Params& p, LAS unsigned char* lds) {
    constexpr int SB = ScanCfg<PASS2>::SB; constexpr int NV = PASS2 ? 8 : 6;
    const int tid = threadIdx.x, lane = tid & 63, wave = tid >> 6, G = gridDim.x;
    const int gw = blockIdx.x * NWAVES + wave, NGW = G * NWAVES;
    unsigned char* ws = p.ws;
    const float* DEC = (const float*)(ws + WS_DEC);
    const bf16* R = (const bf16*)p.out; const bf16* KF = R + (size_t)T * DB; const bf16* V = KF + (size_t)T * DB; const bf16* KKN = V + (size_t)T * DB; const bf16* Bv = (const bf16*)(ws + WS_B);
    const bf16* Gt = (const bf16*)(ws + WS_G); const float* BON = (const float*)(ws + WS_BONUS); bf16* YB = (bf16*)(ws + WS_YB);
    float* ST = (float*)(ws + WS_ST); float* YT = (float*)p.out; bf16* ZT = (bf16*)p.out + (size_t)3 * T * DB;
    const bf16* FEAT = (const bf16*)(ws + WS_FEAT); const bf16* AS = (const bf16*)(ws + WS_AS); bf16* Vw = (bf16*)p.out + (size_t)2 * T * DB; float* BONw = (float*)(ws + WS_BONUS);
    LAS float* buf = (LAS float*)(lds + wave * 16384);
    for (int u = gw; u < 32 * NCH; u += NGW) {
        const int bh = u / NCH, ch = u % NCH, b = bh >> 4, h = bh & 15; int lnl = lane; asm volatile("" : "+v"(lnl));
        const unsigned i0 = (unsigned)((b * SEQ + ch * CL) * DB + h * 64) + (unsigned)lnl;
        const unsigned q0 = (unsigned)((b * SEQ + ch * CL) * NH + h);
        const unsigned f0 = (unsigned)((b * SEQ + ch * CL) * 3072 + h * 64) + (unsigned)lnl;
        const int cc_ = h * 64 + lnl;
        const float mur = p.in[I_MU][cc_], muk = p.in[I_MU][1024 + cc_], muv = p.in[I_MU][2048 + cc_], ckk = p.in[I_KK][cc_], cka = p.in[I_KA][cc_], crk = p.in[I_RK][cc_];
        float pr = 0.f, pk = 0.f, pv = 0.f;
        if (ch > 0) { pr = bf2f(FEAT[f0 - 3072u]); pk = bf2f(FEAT[f0 - 3072u + 1024]); pv = bf2f(FEAT[f0 - 3072u + 2048]); }
        f32x2 Q2[32], P2[32];
#pragma unroll
        for (int k = 0; k < 32; ++k) { Q2[k] = (f32x2){0.f, 0.f}; P2[k] = (f32x2){(2 * k == lnl) ? 1.f : 0.f, (2 * k + 1 == lnl) ? 1.f : 0.f}; }
        float lw = 0.f, lb = 0.f;
        if (PASS2) { lw = p.in[I_LNW][h * 64 + lane]; lb = p.in[I_LNB][h * 64 + lane];
            if (ch > 0) { const f32x4* s = (const f32x4*)(ST + ((size_t)(u - 1) * 2) * 4096 + lane * 64);
#pragma unroll
                for (int j = 0; j < 16; ++j) { const f32x4 x = s[j]; Q2[2 * j] = x.xy; Q2[2 * j + 1] = x.zw; } } }
        float rg[SB][NV];
#define SCAN_LOAD(seg) do { _Pragma("unroll") for (int s = 0; s < SB; ++s) { const unsigned st_ = (unsigned)((seg) * SB + s); const unsigned ix = i0 + st_ * DB, fx = f0 + st_ * 3072u; \
            rg[s][0] = DEC[ix]; rg[s][1] = bf2f(FEAT[fx]); rg[s][2] = bf2f(FEAT[fx + 1024]); rg[s][3] = bf2f(FEAT[fx + 2048]); rg[s][4] = bf2f(AS[ix]); } } while (0)
#define SCAN_STORE(bi, seg) do { _Pragma("unroll") for (int s = 0; s < SB; ++s) { const unsigned st_ = (unsigned)((seg) * SB + s); \
            const float cr_ = rg[s][1], ck_ = rg[s][2], cv_ = rg[s][3], a_ = rg[s][4]; \
            const float r_ = cr_ + (pr - cr_) * mur, k_ = ck_ + (pk - ck_) * muk, v_ = cv_ + (pv - cv_) * muv; pr = cr_; pk = ck_; pv = cv_; \
            const float kk_ = k_ * ckk, kf_ = k_ * (1.0f + (a_ - 1.0f) * cka); float n2_ = kk_ * kk_, bon_ = r_ * kf_ * crk; wave_sum2(n2_, bon_); \
            const float kkn_ = kk_ * __builtin_amdgcn_rsqf(fmaxf(n2_, 1e-24f)); \
            LAS float* d_ = buf + (((bi) * SB + s) * NV) * 64 + lane; d_[0] = rg[s][0]; d_[64] = kkn_; d_[128] = kkn_ * a_; d_[192] = kf_; d_[256] = v_; d_[320] = r_; \
            if (MODE == 0) { Vw[i0 + st_ * DB] = (bf16)f2bf(v_); if (lane == 0) BONw[q0 + st_ * NH] = bon_; } } } while (0)
        SCAN_LOAD(0); SCAN_STORE(0, 0);
        for (int seg = 0; seg < CL / SB; ++seg) {
            const int bi = seg & 1;
            if (MODE != 2 && seg + 1 < CL / SB) SCAN_LOAD(seg + 1);
            asm volatile("" ::: "memory");
#define RLF_UNUSED 0
#define DPPFMAC(acc, rep, val, n) asm("v_fmac_f32_dpp %0, %1, %2 row_newbcast:" #n " row_mask:0xf bank_mask:0xf" : "+v"(acc) : "v"(rep), "v"(val))
#pragma unroll 1
            for (int s = 0; s < (MODE == 1 ? 0 : SB); ++s) {
                const LAS float* sv = buf + ((bi * SB + s) * NV) * 64;
                const LAS f32x4* L4 = (const LAS f32x4*)sv;
                f32x2 qloa = {0.f, 0.f}, qhia = qloa, qlob = qloa, qhib = qloa, plo = qloa, phi = qloa, yloa = qloa, yhia = qloa, ylob = qloa, yhib = qloa, saq2 = qloa, sap2 = qloa;
                const float vv = sv[4 * 64 + lane]; const f32x2 vv2 = {vv, vv};
                const float xk = sv[1 * 64 + lane], xb = sv[2 * 64 + lane], xr = sv[5 * 64 + lane];
                float qd0 = 0.f, qd1 = 0.f, qd2 = 0.f, qd3 = 0.f, pd0 = 0.f, pd1 = 0.f, pd2 = 0.f, pd3 = 0.f, yd0 = 0.f, yd1 = 0.f, yd2 = 0.f, yd3 = 0.f, zd0 = 0.f, zd1 = 0.f, zd2 = 0.f, zd3 = 0.f;
                const int l15 = lane & 15; float xkq0 = sv[64 + l15], xkq1 = sv[64 + 16 + l15], xkq2 = sv[64 + 32 + l15], xkq3 = sv[64 + 48 + l15], xrq0 = sv[320 + l15], xrq1 = sv[320 + 16 + l15], xrq2 = sv[320 + 32 + l15], xrq3 = sv[320 + 48 + l15];
                asm volatile("s_nop 1" : "+v"(xkq0), "+v"(xkq1), "+v"(xkq2), "+v"(xkq3));
                if constexpr (PASS2) {
                __builtin_amdgcn_sched_barrier(0);
                { const f32x2 kxy = (f32x2){RLF(xk, 0), RLF(xk, 1)}, kzw = (f32x2){RLF(xk, 2), RLF(xk, 3)};
                qloa += Q2[0] * kxy; qhia += Q2[1] * kzw; }
                { const f32x2 kxy = (f32x2){RLF(xk, 4), RLF(xk, 5)}, kzw = (f32x2){RLF(xk, 6), RLF(xk, 7)};
                qlob += Q2[2] * kxy; qhib += Q2[3] * kzw; }
                { const f32x2 kxy = (f32x2){RLF(xk, 8), RLF(xk, 9)}, kzw = (f32x2){RLF(xk, 10), RLF(xk, 11)};
                qloa += Q2[4] * kxy; qhia += Q2[5] * kzw; }
                { const f32x2 kxy = (f32x2){RLF(xk, 12), RLF(xk, 13)}, kzw = (f32x2){RLF(xk, 14), RLF(xk, 15)};
                qlob += Q2[6] * kxy; qhib += Q2[7] * kzw; }
                __builtin_amdgcn_sched_barrier(0);
                { const f32x2 kxy = (f32x2){RLF(xk, 16), RLF(xk, 17)}, kzw = (f32x2){RLF(xk, 18), RLF(xk, 19)};
                qloa += Q2[8] * kxy; qhia += Q2[9] * kzw; }
                { const f32x2 kxy = (f32x2){RLF(xk, 20), RLF(xk, 21)}, kzw = (f32x2){RLF(xk, 22), RLF(xk, 23)};
                qlob += Q2[10] * kxy; qhib += Q2[11] * kzw; }
                { const f32x2 kxy = (f32x2){RLF(xk, 24), RLF(xk, 25)}, kzw = (f32x2){RLF(xk, 26), RLF(xk, 27)};
                qloa += Q2[12] * kxy; qhia += Q2[13] * kzw; }
                { const f32x2 kxy = (f32x2){RLF(xk, 28), RLF(xk, 29)}, kzw = (f32x2){RLF(xk, 30), RLF(xk, 31)};
                qlob += Q2[14] * kxy; qhib += Q2[15] * kzw; }
                __builtin_amdgcn_sched_barrier(0);
                f32x4 d_0 = L4[0], k_0 = L4[48];
                f32x4 r_0 = L4[80];
                f32x4 d_1 = L4[1], k_1 = L4[49];
                f32x4 r_1 = L4[81];
                { const f32x2 kxy = (f32x2){RLF(xk, 32), RLF(xk, 33)}, kzw = (f32x2){RLF(xk, 34), RLF(xk, 35)};
                qloa += Q2[16] * kxy; qhia += Q2[17] * kzw; }
                { const f32x2 kxy = (f32x2){RLF(xk, 36), RLF(xk, 37)}, kzw = (f32x2){RLF(xk, 38), RLF(xk, 39)};
                qlob += Q2[18] * kxy; qhib += Q2[19] * kzw; }
                { const f32x2 kxy = (f32x2){RLF(xk, 40), RLF(xk, 41)}, kzw = (f32x2){RLF(xk, 42), RLF(xk, 43)};
                qloa += Q2[20] * kxy; qhia += Q2[21] * kzw; }
                { const f32x2 kxy = (f32x2){RLF(xk, 44), RLF(xk, 45)}, kzw = (f32x2){RLF(xk, 46), RLF(xk, 47)};
                qlob += Q2[22] * kxy; qhib += Q2[23] * kzw; }
                __builtin_amdgcn_sched_barrier(0);
                f32x4 d_2 = L4[2], k_2 = L4[50];
                f32x4 r_2 = L4[82];
                f32x4 d_3 = L4[3], k_3 = L4[51];
                f32x4 r_3 = L4[83];
                { const f32x2 kxy = (f32x2){RLF(xk, 48), RLF(xk, 49)}, kzw = (f32x2){RLF(xk, 50), RLF(xk, 51)};
                qloa += Q2[24] * kxy; qhia += Q2[25] * kzw; }
                { const f32x2 kxy = (f32x2){RLF(xk, 52), RLF(xk, 53)}, kzw = (f32x2){RLF(xk, 54), RLF(xk, 55)};
                qlob += Q2[26] * kxy; qhib += Q2[27] * kzw; }
                { const f32x2 kxy = (f32x2){RLF(xk, 56), RLF(xk, 57)}, kzw = (f32x2){RLF(xk, 58), RLF(xk, 59)};
                qloa += Q2[28] * kxy; qhia += Q2[29] * kzw; }
                { const f32x2 kxy = (f32x2){RLF(xk, 60), RLF(xk, 61)}, kzw = (f32x2){RLF(xk, 62), RLF(xk, 63)};
                qlob += Q2[30] * kxy; qhib += Q2[31] * kzw; }
                { const f32x2 qs = (qloa + qlob) + (qhia + qhib), ps = plo + phi; const float saq = -(qs.x + qs.y), sap = -(ps.x + ps.y); saq2 = (f32x2){saq, saq}; sap2 = (f32x2){sap, sap}; }
                __builtin_amdgcn_sched_barrier(0);
                f32x4 d_4 = L4[4], k_4 = L4[52];
                f32x4 r_4 = L4[84];
                f32x4 d_5 = L4[5], k_5 = L4[53];
                f32x4 r_5 = L4[85];
                { const f32x2 bxy = (f32x2){RLF(xb, 0), RLF(xb, 1)}, bzw = (f32x2){RLF(xb, 2), RLF(xb, 3)};
                Q2[0] = Q2[0] * d_0.xy + (saq2 * bxy + vv2 * k_0.xy); Q2[1] = Q2[1] * d_0.zw + (saq2 * bzw + vv2 * k_0.zw);
                yloa += Q2[0] * r_0.xy; yhia += Q2[1] * r_0.zw; }
                { const f32x2 bxy = (f32x2){RLF(xb, 4), RLF(xb, 5)}, bzw = (f32x2){RLF(xb, 6), RLF(xb, 7)};
                Q2[2] = Q2[2] * d_1.xy + (saq2 * bxy + vv2 * k_1.xy); Q2[3] = Q2[3] * d_1.zw + (saq2 * bzw + vv2 * k_1.zw);
                ylob += Q2[2] * r_1.xy; yhib += Q2[3] * r_1.zw; }
                __builtin_amdgcn_sched_barrier(0);
                f32x4 d_6 = L4[6], k_6 = L4[54];
                f32x4 r_6 = L4[86];
                f32x4 d_7 = L4[7], k_7 = L4[55];
                f32x4 r_7 = L4[87];
                { const f32x2 bxy = (f32x2){RLF(xb, 8), RLF(xb, 9)}, bzw = (f32x2){RLF(xb, 10), RLF(xb, 11)};
                Q2[4] = Q2[4] * d_2.xy + (saq2 * bxy + vv2 * k_2.xy); Q2[5] = Q2[5] * d_2.zw + (saq2 * bzw + vv2 * k_2.zw);
                yloa += Q2[4] * r_2.xy; yhia += Q2[5] * r_2.zw; }
                { const f32x2 bxy = (f32x2){RLF(xb, 12), RLF(xb, 13)}, bzw = (f32x2){RLF(xb, 14), RLF(xb, 15)};
                Q2[6] = Q2[6] * d_3.xy + (saq2 * bxy + vv2 * k_3.xy); Q2[7] = Q2[7] * d_3.zw + (saq2 * bzw + vv2 * k_3.zw);
                ylob += Q2[6] * r_3.xy; yhib += Q2[7] * r_3.zw; }
                __builtin_amdgcn_sched_barrier(0);
                f32x4 d_8 = L4[8], k_8 = L4[56];
                f32x4 r_8 = L4[88];
                f32x4 d_9 = L4[9], k_9 = L4[57];
                f32x4 r_9 = L4[89];
                { const f32x2 bxy = (f32x2){RLF(xb, 16), RLF(xb, 17)}, bzw = (f32x2){RLF(xb, 18), RLF(xb, 19)};
                Q2[8] = Q2[8] * d_4.xy + (saq2 * bxy + vv2 * k_4.xy); Q2[9] = Q2[9] * d_4.zw + (saq2 * bzw + vv2 * k_4.zw);
                yloa += Q2[8] * r_4.xy; yhia += Q2[9] * r_4.zw; }
                { const f32x2 bxy = (f32x2){RLF(xb, 20), RLF(xb, 21)}, bzw = (f32x2){RLF(xb, 22), RLF(xb, 23)};
                Q2[10] = Q2[10] * d_5.xy + (saq2 * bxy + vv2 * k_5.xy); Q2[11] = Q2[11] * d_5.zw + (saq2 * bzw + vv2 * k_5.zw);
                ylob += Q2[10] * r_5.xy; yhib += Q2[11] * r_5.zw; }
                __builtin_amdgcn_sched_barrier(0);
                f32x4 d_10 = L4[10], k_10 = L4[58];
                f32x4 r_10 = L4[90];
                f32x4 d_11 = L4[11], k_11 = L4[59];
                f32x4 r_11 = L4[91];
                { const f32x2 bxy = (f32x2){RLF(xb, 24), RLF(xb, 25)}, bzw = (f32x2){RLF(xb, 26), RLF(xb, 27)};
                Q2[12] = Q2[12] * d_6.xy + (saq2 * bxy + vv2 * k_6.xy); Q2[13] = Q2[13] * d_6.zw + (saq2 * bzw + vv2 * k_6.zw);
                yloa += Q2[12] * r_6.xy; yhia += Q2[13] * r_6.zw; }
                { const f32x2 bxy = (f32x2){RLF(xb, 28), RLF(xb, 29)}, bzw = (f32x2){RLF(xb, 30), RLF(xb, 31)};
                Q2[14] = Q2[14] * d_7.xy + (saq2 * bxy + vv2 * k_7.xy); Q2[15] = Q2[15] * d_7.zw + (saq2 * bzw + vv2 * k_7.zw);
                ylob += Q2[14] * r_7.xy; yhib += Q2[15] * r_7.zw; }
                __builtin_amdgcn_sched_barrier(0);
                f32x4 d_12 = L4[12], k_12 = L4[60];
                f32x4 r_12 = L4[92];
                f32x4 d_13 = L4[13], k_13 = L4[61];
                f32x4 r_13 = L4[93];
                { const f32x2 bxy = (f32x2){RLF(xb, 32), RLF(xb, 33)}, bzw = (f32x2){RLF(xb, 34), RLF(xb, 35)};
                Q2[16] = Q2[16] * d_8.xy + (saq2 * bxy + vv2 * k_8.xy); Q2[17] = Q2[17] * d_8.zw + (saq2 * bzw + vv2 * k_8.zw);
                yloa += Q2[16] * r_8.xy; yhia += Q2[17] * r_8.zw; }
                { const f32x2 bxy = (f32x2){RLF(xb, 36), RLF(xb, 37)}, bzw = (f32x2){RLF(xb, 38), RLF(xb, 39)};
                Q2[18] = Q2[18] * d_9.xy + (saq2 * bxy + vv2 * k_9.xy); Q2[19] = Q2[19] * d_9.zw + (saq2 * bzw + vv2 * k_9.zw);
                ylob += Q2[18] * r_9.xy; yhib += Q2[19] * r_9.zw; }
                __builtin_amdgcn_sched_barrier(0);
                f32x4 d_14 = L4[14], k_14 = L4[62];
                f32x4 r_14 = L4[94];
                f32x4 d_15 = L4[15], k_15 = L4[63];
                f32x4 r_15 = L4[95];
                { const f32x2 bxy = (f32x2){RLF(xb, 40), RLF(xb, 41)}, bzw = (f32x2){RLF(xb, 42), RLF(xb, 43)};
                Q2[20] = Q2[20] * d_10.xy + (saq2 * bxy + vv2 * k_10.xy); Q2[21] = Q2[21] * d_10.zw + (saq2 * bzw + vv2 * k_10.zw);
                yloa += Q2[20] * r_10.xy; yhia += Q2[21] * r_10.zw; }
                { const f32x2 bxy = (f32x2){RLF(xb, 44), RLF(xb, 45)}, bzw = (f32x2){RLF(xb, 46), RLF(xb, 47)};
                Q2[22] = Q2[22] * d_11.xy + (saq2 * bxy + vv2 * k_11.xy); Q2[23] = Q2[23] * d_11.zw + (saq2 * bzw + vv2 * k_11.zw);
                ylob += Q2[22] * r_11.xy; yhib += Q2[23] * r_11.zw; }
                __builtin_amdgcn_sched_barrier(0);
                { const f32x2 bxy = (f32x2){RLF(xb, 48), RLF(xb, 49)}, bzw = (f32x2){RLF(xb, 50), RLF(xb, 51)};
                Q2[24] = Q2[24] * d_12.xy + (saq2 * bxy + vv2 * k_12.xy); Q2[25] = Q2[25] * d_12.zw + (saq2 * bzw + vv2 * k_12.zw);
                yloa += Q2[24] * r_12.xy; yhia += Q2[25] * r_12.zw; }
                { const f32x2 bxy = (f32x2){RLF(xb, 52), RLF(xb, 53)}, bzw = (f32x2){RLF(xb, 54), RLF(xb, 55)};
                Q2[26] = Q2[26] * d_13.xy + (saq2 * bxy + vv2 * k_13.xy); Q2[27] = Q2[27] * d_13.zw + (saq2 * bzw + vv2 * k_13.zw);
                ylob += Q2[26] * r_13.xy; yhib += Q2[27] * r_13.zw; }
                __builtin_amdgcn_sched_barrier(0);
                { const f32x2 bxy = (f32x2){RLF(xb, 56), RLF(xb, 57)}, bzw = (f32x2){RLF(xb, 58), RLF(xb, 59)};
                Q2[28] = Q2[28] * d_14.xy + (saq2 * bxy + vv2 * k_14.xy); Q2[29] = Q2[29] * d_14.zw + (saq2 * bzw + vv2 * k_14.zw);
                yloa += Q2[28] * r_14.xy; yhia += Q2[29] * r_14.zw; }
                { const f32x2 bxy = (f32x2){RLF(xb, 60), RLF(xb, 61)}, bzw = (f32x2){RLF(xb, 62), RLF(xb, 63)};
                Q2[30] = Q2[30] * d_15.xy + (saq2 * bxy + vv2 * k_15.xy); Q2[31] = Q2[31] * d_15.zw + (saq2 * bzw + vv2 * k_15.zw);
                ylob += Q2[30] * r_15.xy; yhib += Q2[31] * r_15.zw; }
                __builtin_amdgcn_sched_barrier(0);
                } else {
                __builtin_amdgcn_sched_barrier(0);
                DPPFMAC(qd0, xkq0, Q2[0].x, 0); DPPFMAC(pd0, xkq0, P2[0].x, 0);
                DPPFMAC(qd1, xkq0, Q2[0].y, 1); DPPFMAC(pd1, xkq0, P2[0].y, 1);
                DPPFMAC(qd2, xkq0, Q2[1].x, 2); DPPFMAC(pd2, xkq0, P2[1].x, 2);
                DPPFMAC(qd3, xkq0, Q2[1].y, 3); DPPFMAC(pd3, xkq0, P2[1].y, 3);
                DPPFMAC(qd0, xkq0, Q2[2].x, 4); DPPFMAC(pd0, xkq0, P2[2].x, 4);
                DPPFMAC(qd1, xkq0, Q2[2].y, 5); DPPFMAC(pd1, xkq0, P2[2].y, 5);
                DPPFMAC(qd2, xkq0, Q2[3].x, 6); DPPFMAC(pd2, xkq0, P2[3].x, 6);
                DPPFMAC(qd3, xkq0, Q2[3].y, 7); DPPFMAC(pd3, xkq0, P2[3].y, 7);
                DPPFMAC(qd0, xkq0, Q2[4].x, 8); DPPFMAC(pd0, xkq0, P2[4].x, 8);
                DPPFMAC(qd1, xkq0, Q2[4].y, 9); DPPFMAC(pd1, xkq0, P2[4].y, 9);
                DPPFMAC(qd2, xkq0, Q2[5].x, 10); DPPFMAC(pd2, xkq0, P2[5].x, 10);
                DPPFMAC(qd3, xkq0, Q2[5].y, 11); DPPFMAC(pd3, xkq0, P2[5].y, 11);
                DPPFMAC(qd0, xkq0, Q2[6].x, 12); DPPFMAC(pd0, xkq0, P2[6].x, 12);
                DPPFMAC(qd1, xkq0, Q2[6].y, 13); DPPFMAC(pd1, xkq0, P2[6].y, 13);
                DPPFMAC(qd2, xkq0, Q2[7].x, 14); DPPFMAC(pd2, xkq0, P2[7].x, 14);
                DPPFMAC(qd3, xkq0, Q2[7].y, 15); DPPFMAC(pd3, xkq0, P2[7].y, 15);
                __builtin_amdgcn_sched_barrier(0);
                DPPFMAC(qd0, xkq1, Q2[8].x, 0); DPPFMAC(pd0, xkq1, P2[8].x, 0);
                DPPFMAC(qd1, xkq1, Q2[8].y, 1); DPPFMAC(pd1, xkq1, P2[8].y, 1);
                DPPFMAC(qd2, xkq1, Q2[9].x, 2); DPPFMAC(pd2, xkq1, P2[9].x, 2);
                DPPFMAC(qd3, xkq1, Q2[9].y, 3); DPPFMAC(pd3, xkq1, P2[9].y, 3);
                DPPFMAC(qd0, xkq1, Q2[10].x, 4); DPPFMAC(pd0, xkq1, P2[10].x, 4);
                DPPFMAC(qd1, xkq1, Q2[10].y, 5); DPPFMAC(pd1, xkq1, P2[10].y, 5);
                DPPFMAC(qd2, xkq1, Q2[11].x, 6); DPPFMAC(pd2, xkq1, P2[11].x, 6);
                DPPFMAC(qd3, xkq1, Q2[11].y, 7); DPPFMAC(pd3, xkq1, P2[11].y, 7);
                DPPFMAC(qd0, xkq1, Q2[12].x, 8); DPPFMAC(pd0, xkq1, P2[12].x, 8);
                DPPFMAC(qd1, xkq1, Q2[12].y, 9); DPPFMAC(pd1, xkq1, P2[12].y, 9);
                DPPFMAC(qd2, xkq1, Q2[13].x, 10); DPPFMAC(pd2, xkq1, P2[13].x, 10);
                DPPFMAC(qd3, xkq1, Q2[13].y, 11); DPPFMAC(pd3, xkq1, P2[13].y, 11);
                DPPFMAC(qd0, xkq1, Q2[14].x, 12); DPPFMAC(pd0, xkq1, P2[14].x, 12);
                DPPFMAC(qd1, xkq1, Q2[14].y, 13); DPPFMAC(pd1, xkq1, P2[14].y, 13);
                DPPFMAC(qd2, xkq1, Q2[15].x, 14); DPPFMAC(pd2, xkq1, P2[15].x, 14);
                DPPFMAC(qd3, xkq1, Q2[15].y, 15); DPPFMAC(pd3, xkq1, P2[15].y, 15);
                __builtin_amdgcn_sched_barrier(0);
                DPPFMAC(qd0, xkq2, Q2[16].x, 0); DPPFMAC(pd0, xkq2, P2[16].x, 0);
                DPPFMAC(qd1, xkq2, Q2[16].y, 1); DPPFMAC(pd1, xkq2, P2[16].y, 1);
                DPPFMAC(qd2, xkq2, Q2[17].x, 2); DPPFMAC(pd2, xkq2, P2[17].x, 2);
                DPPFMAC(qd3, xkq2, Q2[17].y, 3); DPPFMAC(pd3, xkq2, P2[17].y, 3);
                DPPFMAC(qd0, xkq2, Q2[18].x, 4); DPPFMAC(pd0, xkq2, P2[18].x, 4);
                DPPFMAC(qd1, xkq2, Q2[18].y, 5); DPPFMAC(pd1, xkq2, P2[18].y, 5);
                DPPFMAC(qd2, xkq2, Q2[19].x, 6); DPPFMAC(pd2, xkq2, P2[19].x, 6);
                DPPFMAC(qd3, xkq2, Q2[19].y, 7); DPPFMAC(pd3, xkq2, P2[19].y, 7);
                DPPFMAC(qd0, xkq2, Q2[20].x, 8); DPPFMAC(pd0, xkq2, P2[20].x, 8);
                DPPFMAC(qd1, xkq2, Q2[20].y, 9); DPPFMAC(pd1, xkq2, P2[20].y, 9);
                DPPFMAC(qd2, xkq2, Q2[21].x, 10); DPPFMAC(pd2, xkq2, P2[21].x, 10);
                DPPFMAC(qd3, xkq2, Q2[21].y, 11); DPPFMAC(pd3, xkq2, P2[21].y, 11);
                DPPFMAC(qd0, xkq2, Q2[22].x, 12); DPPFMAC(pd0, xkq2, P2[22].x, 12);
                DPPFMAC(qd1, xkq2, Q2[22].y, 13); DPPFMAC(pd1, xkq2, P2[22].y, 13);
                DPPFMAC(qd2, xkq2, Q2[23].x, 14); DPPFMAC(pd2, xkq2, P2[23].x, 14);
                DPPFMAC(qd3, xkq2, Q2[23].y, 15); DPPFMAC(pd3, xkq2, P2[23].y, 15);
                __builtin_amdgcn_sched_barrier(0);
                f32x4 d_0 = L4[0], b_0 = L4[32], k_0 = L4[48];
                f32x4 d_1 = L4[1], b_1 = L4[33], k_1 = L4[49];
                DPPFMAC(qd0, xkq3, Q2[24].x, 0); DPPFMAC(pd0, xkq3, P2[24].x, 0);
                DPPFMAC(qd1, xkq3, Q2[24].y, 1); DPPFMAC(pd1, xkq3, P2[24].y, 1);
                DPPFMAC(qd2, xkq3, Q2[25].x, 2); DPPFMAC(pd2, xkq3, P2[25].x, 2);
                DPPFMAC(qd3, xkq3, Q2[25].y, 3); DPPFMAC(pd3, xkq3, P2[25].y, 3);
                DPPFMAC(qd0, xkq3, Q2[26].x, 4); DPPFMAC(pd0, xkq3, P2[26].x, 4);
                DPPFMAC(qd1, xkq3, Q2[26].y, 5); DPPFMAC(pd1, xkq3, P2[26].y, 5);
                DPPFMAC(qd2, xkq3, Q2[27].x, 6); DPPFMAC(pd2, xkq3, P2[27].x, 6);
                DPPFMAC(qd3, xkq3, Q2[27].y, 7); DPPFMAC(pd3, xkq3, P2[27].y, 7);
                DPPFMAC(qd0, xkq3, Q2[28].x, 8); DPPFMAC(pd0, xkq3, P2[28].x, 8);
                DPPFMAC(qd1, xkq3, Q2[28].y, 9); DPPFMAC(pd1, xkq3, P2[28].y, 9);
                DPPFMAC(qd2, xkq3, Q2[29].x, 10); DPPFMAC(pd2, xkq3, P2[29].x, 10);
                DPPFMAC(qd3, xkq3, Q2[29].y, 11); DPPFMAC(pd3, xkq3, P2[29].y, 11);
                DPPFMAC(qd0, xkq3, Q2[30].x, 12); DPPFMAC(pd0, xkq3, P2[30].x, 12);
                DPPFMAC(qd1, xkq3, Q2[30].y, 13); DPPFMAC(pd1, xkq3, P2[30].y, 13);
                DPPFMAC(qd2, xkq3, Q2[31].x, 14); DPPFMAC(pd2, xkq3, P2[31].x, 14);
                DPPFMAC(qd3, xkq3, Q2[31].y, 15); DPPFMAC(pd3, xkq3, P2[31].y, 15);
                { const float saq = -((qd0 + qd1) + (qd2 + qd3)), sap = -((pd0 + pd1) + (pd2 + pd3)); saq2 = (f32x2){saq, saq}; sap2 = (f32x2){sap, sap}; }
                __builtin_amdgcn_sched_barrier(0);
                f32x4 d_2 = L4[2], b_2 = L4[34], k_2 = L4[50];
                f32x4 d_3 = L4[3], b_3 = L4[35], k_3 = L4[51];
                asm volatile("s_nop 1" : "+v"(xrq0), "+v"(xrq1), "+v"(xrq2), "+v"(xrq3));
                { const f32x2 bxy = b_0.xy, bzw = b_0.zw;
                Q2[0] = Q2[0] * d_0.xy + (saq2 * bxy + vv2 * k_0.xy); Q2[1] = Q2[1] * d_0.zw + (saq2 * bzw + vv2 * k_0.zw);
                P2[0] = P2[0] * d_0.xy + sap2 * bxy; P2[1] = P2[1] * d_0.zw + sap2 * bzw;
                DPPFMAC(yd0, xrq0, Q2[0].x, 0); DPPFMAC(zd0, xrq0, P2[0].x, 0);
                DPPFMAC(yd1, xrq0, Q2[0].y, 1); DPPFMAC(zd1, xrq0, P2[0].y, 1);
                DPPFMAC(yd2, xrq0, Q2[1].x, 2); DPPFMAC(zd2, xrq0, P2[1].x, 2);
                DPPFMAC(yd3, xrq0, Q2[1].y, 3); DPPFMAC(zd3, xrq0, P2[1].y, 3);
                }
                { const f32x2 bxy = b_1.xy, bzw = b_1.zw;
                Q2[2] = Q2[2] * d_1.xy + (saq2 * bxy + vv2 * k_1.xy); Q2[3] = Q2[3] * d_1.zw + (saq2 * bzw + vv2 * k_1.zw);
                P2[2] = P2[2] * d_1.xy + sap2 * bxy; P2[3] = P2[3] * d_1.zw + sap2 * bzw;
                DPPFMAC(yd0, xrq0, Q2[2].x, 4); DPPFMAC(zd0, xrq0, P2[2].x, 4);
                DPPFMAC(yd1, xrq0, Q2[2].y, 5); DPPFMAC(zd1, xrq0, P2[2].y, 5);
                DPPFMAC(yd2, xrq0, Q2[3].x, 6); DPPFMAC(zd2, xrq0, P2[3].x, 6);
                DPPFMAC(yd3, xrq0, Q2[3].y, 7); DPPFMAC(zd3, xrq0, P2[3].y, 7);
                }
                __builtin_amdgcn_sched_barrier(0);
                f32x4 d_4 = L4[4], b_4 = L4[36], k_4 = L4[52];
                f32x4 d_5 = L4[5], b_5 = L4[37], k_5 = L4[53];
                { const f32x2 bxy = b_2.xy, bzw = b_2.zw;
                Q2[4] = Q2[4] * d_2.xy + (saq2 * bxy + vv2 * k_2.xy); Q2[5] = Q2[5] * d_2.zw + (saq2 * bzw + vv2 * k_2.zw);
                P2[4] = P2[4] * d_2.xy + sap2 * bxy; P2[5] = P2[5] * d_2.zw + sap2 * bzw;
                DPPFMAC(yd0, xrq0, Q2[4].x, 8); DPPFMAC(zd0, xrq0, P2[4].x, 8);
                DPPFMAC(yd1, xrq0, Q2[4].y, 9); DPPFMAC(zd1, xrq0, P2[4].y, 9);
                DPPFMAC(yd2, xrq0, Q2[5].x, 10); DPPFMAC(zd2, xrq0, P2[5].x, 10);
                DPPFMAC(yd3, xrq0, Q2[5].y, 11); DPPFMAC(zd3, xrq0, P2[5].y, 11);
                }
                { const f32x2 bxy = b_3.xy, bzw = b_3.zw;
                Q2[6] = Q2[6] * d_3.xy + (saq2 * bxy + vv2 * k_3.xy); Q2[7] = Q2[7] * d_3.zw + (saq2 * bzw + vv2 * k_3.zw);
                P2[6] = P2[6] * d_3.xy + sap2 * bxy; P2[7] = P2[7] * d_3.zw + sap2 * bzw;
                DPPFMAC(yd0, xrq0, Q2[6].x, 12); DPPFMAC(zd0, xrq0, P2[6].x, 12);
                DPPFMAC(yd1, xrq0, Q2[6].y, 13); DPPFMAC(zd1, xrq0, P2[6].y, 13);
                DPPFMAC(yd2, xrq0, Q2[7].x, 14); DPPFMAC(zd2, xrq0, P2[7].x, 14);
                DPPFMAC(yd3, xrq0, Q2[7].y, 15); DPPFMAC(zd3, xrq0, P2[7].y, 15);
                }
                __builtin_amdgcn_sched_barrier(0);
                f32x4 d_6 = L4[6], b_6 = L4[38], k_6 = L4[54];
                f32x4 d_7 = L4[7], b_7 = L4[39], k_7 = L4[55];
                { const f32x2 bxy = b_4.xy, bzw = b_4.zw;
                Q2[8] = Q2[8] * d_4.xy + (saq2 * bxy + vv2 * k_4.xy); Q2[9] = Q2[9] * d_4.zw + (saq2 * bzw + vv2 * k_4.zw);
                P2[8] = P2[8] * d_4.xy + sap2 * bxy; P2[9] = P2[9] * d_4.zw + sap2 * bzw;
                DPPFMAC(yd0, xrq1, Q2[8].x, 0); DPPFMAC(zd0, xrq1, P2[8].x, 0);
                DPPFMAC(yd1, xrq1, Q2[8].y, 1); DPPFMAC(zd1, xrq1, P2[8].y, 1);
                DPPFMAC(yd2, xrq1, Q2[9].x, 2); DPPFMAC(zd2, xrq1, P2[9].x, 2);
                DPPFMAC(yd3, xrq1, Q2[9].y, 3); DPPFMAC(zd3, xrq1, P2[9].y, 3);
                }
                { const f32x2 bxy = b_5.xy, bzw = b_5.zw;
                Q2[10] = Q2[10] * d_5.xy + (saq2 * bxy + vv2 * k_5.xy); Q2[11] = Q2[11] * d_5.zw + (saq2 * bzw + vv2 * k_5.zw);
                P2[10] = P2[10] * d_5.xy + sap2 * bxy; P2[11] = P2[11] * d_5.zw + sap2 * bzw;
                DPPFMAC(yd0, xrq1, Q2[10].x, 4); DPPFMAC(zd0, xrq1, P2[10].x, 4);
                DPPFMAC(yd1, xrq1, Q2[10].y, 5); DPPFMAC(zd1, xrq1, P2[10].y, 5);
                DPPFMAC(yd2, xrq1, Q2[11].x, 6); DPPFMAC(zd2, xrq1, P2[11].x, 6);
                DPPFMAC(yd3, xrq1, Q2[11].y, 7); DPPFMAC(zd3, xrq1, P2[11].y, 7);
                }
                __builtin_amdgcn_sched_barrier(0);
                f32x4 d_8 = L4[8], b_8 = L4[40], k_8 = L4[56];
                f32x4 d_9 = L4[9], b_9 = L4[41], k_9 = L4[57];
                { const f32x2 bxy = b_6.xy, bzw = b_6.zw;
                Q2[12] = Q2[12] * d_6.xy + (saq2 * bxy + vv2 * k_6.xy); Q2[13] = Q2[13] * d_6.zw + (saq2 * bzw + vv2 * k_6.zw);
                P2[12] = P2[12] * d_6.xy + sap2 * bxy; P2[13] = P2[13] * d_6.zw + sap2 * bzw;
                DPPFMAC(yd0, xrq1, Q2[12].x, 8); DPPFMAC(zd0, xrq1, P2[12].x, 8);
                DPPFMAC(yd1, xrq1, Q2[12].y, 9); DPPFMAC(zd1, xrq1, P2[12].y, 9);
                DPPFMAC(yd2, xrq1, Q2[13].x, 10); DPPFMAC(zd2, xrq1, P2[13].x, 10);
                DPPFMAC(yd3, xrq1, Q2[13].y, 11); DPPFMAC(zd3, xrq1, P2[13].y, 11);
                }
                { const f32x2 bxy = b_7.xy, bzw = b_7.zw;
                Q2[14] = Q2[14] * d_7.xy + (saq2 * bxy + vv2 * k_7.xy); Q2[15] = Q2[15] * d_7.zw + (saq2 * bzw + vv2 * k_7.zw);
                P2[14] = P2[14] * d_7.xy + sap2 * bxy; P2[15] = P2[15] * d_7.zw + sap2 * bzw;
                DPPFMAC(yd0, xrq1, Q2[14].x, 12); DPPFMAC(zd0, xrq1, P2[14].x, 12);
                DPPFMAC(yd1, xrq1, Q2[14].y, 13); DPPFMAC(zd1, xrq1, P2[14].y, 13);
                DPPFMAC(yd2, xrq1, Q2[15].x, 14); DPPFMAC(zd2, xrq1, P2[15].x, 14);
                DPPFMAC(yd3, xrq1, Q2[15].y, 15); DPPFMAC(zd3, xrq1, P2[15].y, 15);
                }
                __builtin_amdgcn_sched_barrier(0);
                f32x4 d_10 = L4[10], b_10 = L4[42], k_10 = L4[58];
                f32x4 d_11 = L4[11], b_11 = L4[43], k_11 = L4[59];
                { const f32x2 bxy = b_8.xy, bzw = b_8.zw;
                Q2[16] = Q2[16] * d_8.xy + (saq2 * bxy + vv2 * k_8.xy); Q2[17] = Q2[17] * d_8.zw + (saq2 * bzw + vv2 * k_8.zw);
                P2[16] = P2[16] * d_8.xy + sap2 * bxy; P2[17] = P2[17] * d_8.zw + sap2 * bzw;
                DPPFMAC(yd0, xrq2, Q2[16].x, 0); DPPFMAC(zd0, xrq2, P2[16].x, 0);
                DPPFMAC(yd1, xrq2, Q2[16].y, 1); DPPFMAC(zd1, xrq2, P2[16].y, 1);
                DPPFMAC(yd2, xrq2, Q2[17].x, 2); DPPFMAC(zd2, xrq2, P2[17].x, 2);
                DPPFMAC(yd3, xrq2, Q2[17].y, 3); DPPFMAC(zd3, xrq2, P2[17].y, 3);
                }
                { const f32x2 bxy = b_9.xy, bzw = b_9.zw;
                Q2[18] = Q2[18] * d_9.xy + (saq2 * bxy + vv2 * k_9.xy); Q2[19] = Q2[19] * d_9.zw + (saq2 * bzw + vv2 * k_9.zw);
                P2[18] = P2[18] * d_9.xy + sap2 * bxy; P2[19] = P2[19] * d_9.zw + sap2 * bzw;
                DPPFMAC(yd0, xrq2, Q2[18].x, 4); DPPFMAC(zd0, xrq2, P2[18].x, 4);
                DPPFMAC(yd1, xrq2, Q2[18].y, 5); DPPFMAC(zd1, xrq2, P2[18].y, 5);
                DPPFMAC(yd2, xrq2, Q2[19].x, 6); DPPFMAC(zd2, xrq2, P2[19].x, 6);
                DPPFMAC(yd3, xrq2, Q2[19].y, 7); DPPFMAC(zd3, xrq2, P2[19].y, 7);
                }
                __builtin_amdgcn_sched_barrier(0);
                f32x4 d_12 = L4[12], b_12 = L4[44], k_12 = L4[60];
                f32x4 d_13 = L4[13], b_13 = L4[45], k_13 = L4[61];
                { const f32x2 bxy = b_10.xy, bzw = b_10.zw;
                Q2[20] = Q2[20] * d_10.xy + (saq2 * bxy + vv2 * k_10.xy); Q2[21] = Q2[21] * d_10.zw + (saq2 * bzw + vv2 * k_10.zw);
                P2[20] = P2[20] * d_10.xy + sap2 * bxy; P2[21] = P2[21] * d_10.zw + sap2 * bzw;
                DPPFMAC(yd0, xrq2, Q2[20].x, 8); DPPFMAC(zd0, xrq2, P2[20].x, 8);
                DPPFMAC(yd1, xrq2, Q2[20].y, 9); DPPFMAC(zd1, xrq2, P2[20].y, 9);
                DPPFMAC(yd2, xrq2, Q2[21].x, 10); DPPFMAC(zd2, xrq2, P2[21].x, 10);
                DPPFMAC(yd3, xrq2, Q2[21].y, 11); DPPFMAC(zd3, xrq2, P2[21].y, 11);
                }
                { const f32x2 bxy = b_11.xy, bzw = b_11.zw;
                Q2[22] = Q2[22] * d_11.xy + (saq2 * bxy + vv2 * k_11.xy); Q2[23] = Q2[23] * d_11.zw + (saq2 * bzw + vv2 * k_11.zw);
                P2[22] = P2[22] * d_11.xy + sap2 * bxy; P2[23] = P2[23] * d_11.zw + sap2 * bzw;
                DPPFMAC(yd0, xrq2, Q2[22].x, 12); DPPFMAC(zd0, xrq2, P2[22].x, 12);
                DPPFMAC(yd1, xrq2, Q2[22].y, 13); DPPFMAC(zd1, xrq2, P2[22].y, 13);
                DPPFMAC(yd2, xrq2, Q2[23].x, 14); DPPFMAC(zd2, xrq2, P2[23].x, 14);
                DPPFMAC(yd3, xrq2, Q2[23].y, 15); DPPFMAC(zd3, xrq2, P2[23].y, 15);
                }
                __builtin_amdgcn_sched_barrier(0);
                f32x4 d_14 = L4[14], b_14 = L4[46], k_14 = L4[62];
                f32x4 d_15 = L4[15], b_15 = L4[47], k_15 = L4[63];
                { const f32x2 bxy = b_12.xy, bzw = b_12.zw;
                Q2[24] = Q2[24] * d_12.xy + (saq2 * bxy + vv2 * k_12.xy); Q2[25] = Q2[25] * d_12.zw + (saq2 * bzw + vv2 * k_12.zw);
                P2[24] = P2[24] * d_12.xy + sap2 * bxy; P2[25] = P2[25] * d_12.zw + sap2 * bzw;
                DPPFMAC(yd0, xrq3, Q2[24].x, 0); DPPFMAC(zd0, xrq3, P2[24].x, 0);
                DPPFMAC(yd1, xrq3, Q2[24].y, 1); DPPFMAC(zd1, xrq3, P2[24].y, 1);
                DPPFMAC(yd2, xrq3, Q2[25].x, 2); DPPFMAC(zd2, xrq3, P2[25].x, 2);
                DPPFMAC(yd3, xrq3, Q2[25].y, 3); DPPFMAC(zd3, xrq3, P2[25].y, 3);
                }
                { const f32x2 bxy = b_13.xy, bzw = b_13.zw;
                Q2[26] = Q2[26] * d_13.xy + (saq2 * bxy + vv2 * k_13.xy); Q2[27] = Q2[27] * d_13.zw + (saq2 * bzw + vv2 * k_13.zw);
                P2[26] = P2[26] * d_13.xy + sap2 * bxy; P2[27] = P2[27] * d_13.zw + sap2 * bzw;
                DPPFMAC(yd0, xrq3, Q2[26].x, 4); DPPFMAC(zd0, xrq3, P2[26].x, 4);
                DPPFMAC(yd1, xrq3, Q2[26].y, 5); DPPFMAC(zd1, xrq3, P2[26].y, 5);
                DPPFMAC(yd2, xrq3, Q2[27].x, 6); DPPFMAC(zd2, xrq3, P2[27].x, 6);
                DPPFMAC(yd3, xrq3, Q2[27].y, 7); DPPFMAC(zd3, xrq3, P2[27].y, 7);
                }
                __builtin_amdgcn_sched_barrier(0);
                { const f32x2 bxy = b_14.xy, bzw = b_14.zw;
                Q2[28] = Q2[28] * d_14.xy + (saq2 * bxy + vv2 * k_14.xy); Q2[29] = Q2[29] * d_14.zw + (saq2 * bzw + vv2 * k_14.zw);
                P2[28] = P2[28] * d_14.xy + sap2 * bxy; P2[29] = P2[29] * d_14.zw + sap2 * bzw;
                DPPFMAC(yd0, xrq3, Q2[28].x, 8); DPPFMAC(zd0, xrq3, P2[28].x, 8);
                DPPFMAC(yd1, xrq3, Q2[28].y, 9); DPPFMAC(zd1, xrq3, P2[28].y, 9);
                DPPFMAC(yd2, xrq3, Q2[29].x, 10); DPPFMAC(zd2, xrq3, P2[29].x, 10);
                DPPFMAC(yd3, xrq3, Q2[29].y, 11); DPPFMAC(zd3, xrq3, P2[29].y, 11);
                }
                { const f32x2 bxy = b_15.xy, bzw = b_15.zw;
                Q2[30] = Q2[30] * d_15.xy + (saq2 * bxy + vv2 * k_15.xy); Q2[31] = Q2[31] * d_15.zw + (saq2 * bzw + vv2 * k_15.zw);
                P2[30] = P2[30] * d_15.xy + sap2 * bxy; P2[31] = P2[31] * d_15.zw + sap2 * bzw;
                DPPFMAC(yd0, xrq3, Q2[30].x, 12); DPPFMAC(zd0, xrq3, P2[30].x, 12);
                DPPFMAC(yd1, xrq3, Q2[30].y, 13); DPPFMAC(zd1, xrq3, P2[30].y, 13);
                DPPFMAC(yd2, xrq3, Q2[31].x, 14); DPPFMAC(zd2, xrq3, P2[31].x, 14);
                DPPFMAC(yd3, xrq3, Q2[31].y, 15); DPPFMAC(zd3, xrq3, P2[31].y, 15);
                }
                __builtin_amdgcn_sched_barrier(0);
                }
                if (!PASS2 && MODE == 0) {
                    const unsigned ox = i0 + (unsigned)((seg * SB + s) * DB);
                    YT[ox] = (yd0 + yd1) + (yd2 + yd3); ZT[ox] = (bf16)f2bf((zd0 + zd1) + (zd2 + zd3));
                }
                if (PASS2) {
                    const f32x2 ys = (yloa + ylob) + (yhia + yhib);
                    const float y = ys.x + ys.y;
                    float s1 = y, s2 = y * y; wave_sum2(s1, s2);
                    const float mean = s1 * (1.0f / 64.0f); const float var = fmaxf(s2 * (1.0f / 64.0f) - mean * mean, 0.f);
                    const float yn = (y - mean) * (1.0f / sqrtf(var + 64e-5f)) * lw + lb;
                    const float o = (yn + sv[7 * 64 + lane] * vv) * sv[6 * 64 + lane];
                    YB[i0 + (unsigned)((seg * SB + s) * DB)] = (bf16)f2bf(o);
                }
            }
            asm volatile("" ::: "memory");
            if (MODE != 2 && seg + 1 < CL / SB) SCAN_STORE(bi ^ 1, seg + 1);
            asm volatile("" ::: "memory");
        }
#undef SCAN_LOAD
#undef SCAN_STORE
        if (MODE != 0) { float acc_ = 0.f; _Pragma("unroll") for (int k = 0; k < 32; ++k) acc_ += Q2[k].x + Q2[k].y + P2[k].x + P2[k].y; if (acc_ == 123.456f) ST[0] = acc_; }
        if (!PASS2 && MODE == 0) { f32x4* sq = (f32x4*)(ST + ((size_t)u * 2) * 4096 + lane * 64); f32x4* sp = (f32x4*)(ST + ((size_t)u * 2 + 1) * 4096 + lane * 64);
#pragma unroll
            for (int j = 0; j < 16; ++j) { sq[j] = (f32x4){Q2[2 * j].x, Q2[2 * j].y, Q2[2 * j + 1].x, Q2[2 * j + 1].y}; sp[j] = (f32x4){P2[2 * j].x, P2[2 * j].y, P2[2 * j + 1].x, P2[2 * j + 1].y}; } }
    }
}

#define DPPR(v, ctrl) __int_as_float(__builtin_amdgcn_update_dpp(0, __float_as_int(v), ctrl, 0xf, 0xf, false))
__device__ __forceinline__ float row16_allsum(float v) { v += DPPR(v, 0xB1); v += DPPR(v, 0x4E); v += DPPR(v, 0x141); v += DPPR(v, 0x140); return v; }
struct P2Tile { u32x4 z0, z1; f32x4 yt[4]; u32x2 vv[4], gg[4]; float bo; };
__device__ __forceinline__ void phase_scan2z(const Params& p) {
    const int tid = threadIdx.x, lane = tid & 63, wave = tid >> 6, G = gridDim.x;
    const int gw = blockIdx.x * NWAVES + wave, NGW = G * NWAVES;
    unsigned char* ws = p.ws;
    const bf16* V = (const bf16*)p.out + (size_t)2 * T * DB; const bf16* Gt = (const bf16*)(ws + WS_G); const float* BON = (const float*)(ws + WS_BONUS); bf16* YB = (bf16*)(ws + WS_YB);
    const float* ST = (const float*)(ws + WS_ST); const float* YT = (const float*)p.out; const bf16* ZT = (const bf16*)p.out + (size_t)3 * T * DB;
    for (int u = gw; u < 32 * NCH; u += NGW) {
        const int bh = u / NCH, ch = u % NCH, b = bh >> 4, h = bh & 15; int lnl = lane; asm volatile("" : "+v"(lnl));
        const int lr = lnl & 15, lq = lnl >> 4;
        const unsigned t00 = (unsigned)(b * SEQ + ch * CL);
        bf16x8 Sf[4][2];
#pragma unroll
        for (int c = 0; c < 4; ++c)
#pragma unroll
            for (int ks = 0; ks < 2; ++ks) { u32x4 w = (u32x4){0u, 0u, 0u, 0u};
                if (ch > 0) { const float* sp = ST + ((size_t)(u - 1) * 2) * 4096 + (16 * c + lr) * 64 + 32 * ks + 8 * lq; const f32x4 x0 = *(const f32x4*)sp, x1 = *(const f32x4*)(sp + 4);
                    w.x = pk2(x0[0], x0[1]); w.y = pk2(x0[2], x0[3]); w.z = pk2(x1[0], x1[1]); w.w = pk2(x1[2], x1[3]); }
                Sf[c][ks] = __builtin_bit_cast(bf16x8, w); }
        f32x4 lw[4], lb[4];
#pragma unroll
        for (int c = 0; c < 4; ++c) { lw[c] = *(const f32x4*)(p.in[I_LNW] + h * 64 + 16 * c + 4 * lq); lb[c] = *(const f32x4*)(p.in[I_LNB] + h * 64 + 16 * c + 4 * lq); }
#define P2_LOAD(D, tt) do { const unsigned ta_ = t00 + 16u * (tt) + lr; const bf16* zp_ = ZT + (size_t)ta_ * DB + h * 64 + 8 * lq; (D).z0 = *(const u32x4*)zp_; (D).z1 = *(const u32x4*)(zp_ + 32); \
            const size_t o_ = (size_t)ta_ * DB + h * 64 + 4 * lq; (D).bo = BON[ta_ * NH + h]; \
            _Pragma("unroll") for (int c = 0; c < 4; ++c) { (D).yt[c] = *(const f32x4*)(YT + o_ + 16 * c); (D).vv[c] = *(const u32x2*)(V + o_ + 16 * c); (D).gg[c] = *(const u32x2*)(Gt + o_ + 16 * c); } } while (0)
#define P2_COMP(D, tt) do { f32x4 y_[4]; const bf16x8 b0_ = __builtin_bit_cast(bf16x8, (D).z0), b1_ = __builtin_bit_cast(bf16x8, (D).z1); float s1_ = 0.f, s2_ = 0.f; \
            _Pragma("unroll") for (int c = 0; c < 4; ++c) { f32x4 a_ = __builtin_amdgcn_mfma_f32_16x16x32_bf16(Sf[c][0], b0_, (f32x4){0.f, 0.f, 0.f, 0.f}, 0, 0, 0); a_ = __builtin_amdgcn_mfma_f32_16x16x32_bf16(Sf[c][1], b1_, a_, 0, 0, 0); \
                y_[c] = a_ + (D).yt[c]; s1_ += (y_[c][0] + y_[c][1]) + (y_[c][2] + y_[c][3]); s2_ += (y_[c][0] * y_[c][0] + y_[c][1] * y_[c][1]) + (y_[c][2] * y_[c][2] + y_[c][3] * y_[c][3]); } \
            s1_ += __shfl_xor(s1_, 16); s2_ += __shfl_xor(s2_, 16); s1_ += __shfl_xor(s1_, 32); s2_ += __shfl_xor(s2_, 32); \
            const float mean_ = s1_ * (1.0f / 64.0f), rs_ = 1.0f / sqrtf(fmaxf(s2_ * (1.0f / 64.0f) - mean_ * mean_, 0.f) + 64e-5f); \
            const size_t o_ = (size_t)(t00 + 16u * (tt) + lr) * DB + h * 64 + 4 * lq; \
            _Pragma("unroll") for (int c = 0; c < 4; ++c) { const u32x2 vw_ = (D).vv[c], gw_ = (D).gg[c]; \
                const f32x4 v4_ = (f32x4){__uint_as_float(vw_.x << 16), __uint_as_float(vw_.x & 0xffff0000u), __uint_as_float(vw_.y << 16), __uint_as_float(vw_.y & 0xffff0000u)}; \
                const f32x4 g4_ = (f32x4){__uint_as_float(gw_.x << 16), __uint_as_float(gw_.x & 0xffff0000u), __uint_as_float(gw_.y << 16), __uint_as_float(gw_.y & 0xffff0000u)}; \
                const f32x4 o4_ = ((y_[c] - mean_) * rs_ * lw[c] + lb[c] + v4_ * (D).bo) * g4_; u32x2 w_; w_.x = pk2(o4_[0], o4_[1]); w_.y = pk2(o4_[2], o4_[3]); *(u32x2*)(YB + o_ + 16 * c) = w_; } } while (0)
        P2Tile A, B;
        P2_LOAD(A, 0);
#pragma unroll 1
        for (int tt = 0; tt < CL / 16; tt += 2) {
            P2_LOAD(B, tt + 1);
            P2_COMP(A, tt);
            if (tt + 2 < CL / 16) P2_LOAD(A, tt + 2);
            P2_COMP(B, tt + 1);
        }
#undef P2_LOAD
#undef P2_COMP
    }
}

__device__ __forceinline__ void phase_combine(const Params& p, LAS unsigned char* lds) {
    const int tid = threadIdx.x, lane = tid & 63, wave = tid >> 6, G = gridDim.x;
    float* ST = (float*)(p.ws + WS_ST);
    LAS float* PL = (LAS float*)lds;
    if (G > 128 && (int)blockIdx.x >= 128) { convert_weights<1>(p, lds, ((int)blockIdx.x - 128) * NWAVES + wave, (G - 128) * NWAVES); return; }
    for (int bu = blockIdx.x; bu < 32 * 4; bu += G) {
        const int bh = bu >> 2, rq = bu & 3, r0 = rq * 16 + wave * 2;
        const float* base = ST + ((size_t)(bh * NCH) * 2) * 4096;
        float s0 = base[(r0) * 64 + lane], s1 = base[(r0 + 1) * 64 + lane];
        f32x4 pr0, pr1; float q0n, q1n;
        __syncthreads();
        { const f32x4* pp = (const f32x4*)(base + 1 * 8192 + 4096); pr0 = pp[tid]; pr1 = pp[tid + 512]; q0n = base[1 * 8192 + (r0) * 64 + lane]; q1n = base[1 * 8192 + (r0 + 1) * 64 + lane]; }
        *(LAS f32x4*)(PL + 4096 + tid * 4) = pr0; *(LAS f32x4*)(PL + 4096 + (tid + 512) * 4) = pr1;
        __syncthreads();
        for (int c = 1; c < NCH - 1; ++c) {
            const LAS float* Pc = PL + (c & 1) * 4096;
            float n0 = q0n, n1 = q1n;
            if (c + 1 < NCH - 1) { const f32x4* pp = (const f32x4*)(base + (size_t)(c + 1) * 8192 + 4096); pr0 = pp[tid]; pr1 = pp[tid + 512];
                q0n = base[(size_t)(c + 1) * 8192 + (r0) * 64 + lane]; q1n = base[(size_t)(c + 1) * 8192 + (r0 + 1) * 64 + lane]; }
            float a0 = 0.f, a1 = 0.f, b0 = 0.f, b1 = 0.f;
#pragma unroll
            for (int k = 0; k < 64; k += 2) { const float pk0 = Pc[k * 64 + lane], pk1 = Pc[(k + 1) * 64 + lane];
                a0 += __int_as_float(__builtin_amdgcn_readlane(__float_as_int(s0), k)) * pk0; b0 += __int_as_float(__builtin_amdgcn_readlane(__float_as_int(s0), k + 1)) * pk1;
                a1 += __int_as_float(__builtin_amdgcn_readlane(__float_as_int(s1), k)) * pk0; b1 += __int_as_float(__builtin_amdgcn_readlane(__float_as_int(s1), k + 1)) * pk1; }
            s0 = n0 + (a0 + b0); s1 = n1 + (a1 + b1);
            float* Qc = ST + ((size_t)(bh * NCH + c) * 2) * 4096;
            Qc[(r0) * 64 + lane] = s0; Qc[(r0 + 1) * 64 + lane] = s1;
            if (c + 1 < NCH - 1) { LAS float* Pn = PL + ((c + 1) & 1) * 4096; *(LAS f32x4*)(Pn + tid * 4) = pr0; *(LAS f32x4*)(Pn + (tid + 512) * 4) = pr1; }
            __syncthreads();
        }
    }
}

__device__ __forceinline__ void phase_fixup(const Params& p) {
    const int tid = threadIdx.x, G = gridDim.x; unsigned char* ws = p.ws;
    const float* TOP = (const float*)(ws + WS_TOP); const float* BOT = (const float*)(ws + WS_BOT); bf16* ACT = (bf16*)(ws + WS_ACT);
    const float* cw = p.in[I_CW];
    const int gt = blockIdx.x * NTHR + tid, NGT = G * NTHR;
    for (int i0 = gt; i0 < 128 * 2 * DFF; i0 += 4 * NGT) {
        float Cg[4], Cv[4], bg0[4], bg1[4], bv0[4], bv1[4];
#pragma unroll
        for (int u = 0; u < 4; ++u) { const int i = i0 + u * NGT; Cg[u] = Cv[u] = bg0[u] = bg1[u] = bv0[u] = bv1[u] = 0.f;
            if (i < 128 * 2 * DFF) { const int j = i % DFF, row = (i / DFF) & 1, pm = i / (2 * DFF); const int cg_ = (j >> 7) * 256 + (j & 127), cv_ = cg_ + 128;
                Cg[u] = TOP[((size_t)pm * 2 + row) * 11264 + cg_]; Cv[u] = TOP[((size_t)pm * 2 + row) * 11264 + cv_];
                if (pm % 64) { const float* b0 = BOT + ((size_t)(pm - 1) * 2) * 11264; const float* b1 = b0 + 11264; bg0[u] = b0[cg_]; bg1[u] = b1[cg_]; bv0[u] = b0[cv_]; bv1[u] = b1[cv_]; } } }
#pragma unroll
        for (int u = 0; u < 4; ++u) { const int i = i0 + u * NGT;
            if (i < 128 * 2 * DFF) { const int j = i % DFF, row = (i / DFF) & 1, pm = i / (2 * DFF); float g = Cg[u], v = Cv[u];
                if (pm % 64) { if (row == 0) { g += cw[j] * bg0[u] + cw[11264 + j] * bg1[u]; v += cw[5632 + j] * bv0[u] + cw[11264 + 5632 + j] * bv1[u]; }
                               else { g += cw[j] * bg1[u]; v += cw[5632 + j] * bv1[u]; } }
                ACT[(size_t)(pm * 256 + row) * DFF + j] = (bf16)f2bf(gelu_f(g) * v); } } }
}

__device__ __forceinline__ void phase_final(const Params& p) {
    const int tid = threadIdx.x, lane = tid & 63, wave = tid >> 6, G = gridDim.x;
    const int gw = blockIdx.x * NWAVES + wave, NGW = G * NWAVES;
    const float* ssq = (const float*)(p.ws + WS_SSQ2); const f32x4* gr = (const f32x4*)p.in[I_NFG] + lane;
    f32x4 g4[8];
#pragma unroll
    for (int j = 0; j < 8; ++j) g4[j] = gr[64 * j];
    constexpr int UR = 4;
    for (int row0 = gw; row0 < T; row0 += UR * NGW) { f32x4 v[UR][8]; float rs[UR];
#pragma unroll
        for (int u = 0; u < UR; ++u) { const int row = row0 + u * NGW; const f32x4* xr = (const f32x4*)(p.out + (size_t)row * DM) + lane;
#pragma unroll
            for (int j = 0; j < 8; ++j) v[u][j] = xr[64 * j];
            const f32x4* sp = (const f32x4*)(ssq + (size_t)row * 32); f32x4 s = sp[0];
#pragma unroll
            for (int i = 1; i < 8; ++i) s += sp[i];
            rs[u] = 1.0f / sqrtf(((s[0] + s[1]) + (s[2] + s[3])) * (1.0f / DM) + 1e-6f); }
#pragma unroll
        for (int u = 0; u < UR; ++u) { f32x4* xr = (f32x4*)(p.out + (size_t)(row0 + u * NGW) * DM) + lane;
#pragma unroll
            for (int j = 0; j < 8; ++j) __builtin_nontemporal_store(v[u][j] * rs[u] * g4[j], xr + 64 * j); } }
}

#define XB_TMO      128
#define XB_XCNT(j)  (256  + 64 * (j))
#define XB_XSUB(j)  (1280 + 64 * (j))
#define XB_XGEN(j)  (2304 + 64 * (j))
#define XB_TOP      3328
#define XB_TOPGEN   3392
#define XCD_BAR_WORDS 3456
#define XB_SPIN_CAP (1u << 18)

__device__ __forceinline__ unsigned xb_ld(unsigned* p)              { return __hip_atomic_load(p, __ATOMIC_RELAXED, __HIP_MEMORY_SCOPE_AGENT); }
__device__ __forceinline__ unsigned xb_add(unsigned* p, unsigned v) { return __hip_atomic_fetch_add(p, v, __ATOMIC_RELAXED, __HIP_MEMORY_SCOPE_AGENT); }
__device__ __forceinline__ unsigned xb_xcc_id() { return (unsigned)__builtin_amdgcn_s_getreg((3 << 11) | 20) & 0xFu; }
#define XB_SPIN(cond, bar) do { unsigned _sp = 0; while (cond) { __builtin_amdgcn_s_sleep(1); \
    if ((++_sp & 255u) == 0u) { if (xb_ld(&(bar)[XB_TMO])) break; if (_sp > XB_SPIN_CAP) { atomicAdd(&(bar)[XB_TMO], 1u); break; } } } } while (0)

struct XcdBarrier {
    unsigned* bar; unsigned x;
    volatile LAS unsigned* st;
};

__device__ __forceinline__ XcdBarrier xcd_barrier_post(unsigned* bar, volatile LAS unsigned* st) {
    XcdBarrier b; b.bar = bar; b.x = xb_xcc_id(); b.st = st;
    if (threadIdx.x == 0) (void)xb_add(&bar[XB_XCNT(b.x)], 1u);
    return b;
}
__device__ __forceinline__ void xcd_barrier_complete(unsigned* bar, unsigned x, unsigned& nloc, unsigned& nx) {
    const unsigned G = gridDim.x * gridDim.y * gridDim.z;
    unsigned sum, cnt, mine, sp = 0u;
    for (;;) {
        sum = 0u; cnt = 0u; mine = 0u;
#pragma unroll
        for (unsigned j = 0; j < 16; ++j) { const unsigned c = xb_ld(&bar[XB_XCNT(j)]); sum += c; cnt += (c > 0u) ? 1u : 0u; mine = (j == x) ? c : mine; }
        if (sum == G) break;
        __builtin_amdgcn_s_sleep(1);
        if ((++sp & 255u) == 0u) { if (xb_ld(&bar[XB_TMO])) break; if (sp > XB_SPIN_CAP) { atomicAdd(&bar[XB_TMO], 1u); break; } }
    }
    nloc = mine > 0u ? mine : 1u; nx = cnt > 0u ? cnt : 1u;
}

__device__ __forceinline__ void xcd_barrier(const XcdBarrier& b) {
    asm volatile("s_waitcnt vmcnt(0)" ::: "memory");
    __syncthreads();
    if (threadIdx.x == 0) {
        unsigned* bar = b.bar;
        __builtin_amdgcn_s_waitcnt(0);
        unsigned nloc = b.st[0], nx = b.st[1];
        if (nloc == 0u) { xcd_barrier_complete(bar, b.x, nloc, nx); b.st[0] = nloc; b.st[1] = nx; }
        const unsigned old = xb_add(&bar[XB_XSUB(b.x)], 1u);
        const unsigned gen = old / nloc;
        if (old + 1u == (gen + 1u) * nloc) {
            __builtin_amdgcn_fence(__ATOMIC_RELEASE, "agent");
            asm volatile("s_waitcnt vmcnt(0)" ::: "memory");
            const unsigned og = xb_add(&bar[XB_TOP], 1u);
            const unsigned tg = og / nx;
            if (og + 1u == (tg + 1u) * nx) xb_add(&bar[XB_TOPGEN], 1u);
            else XB_SPIN(xb_ld(&bar[XB_TOPGEN]) == tg, bar);
            __builtin_amdgcn_fence(__ATOMIC_ACQUIRE, "agent");
            xb_add(&bar[XB_XGEN(b.x)], 1u);
            asm volatile("s_waitcnt vmcnt(0)" ::: "memory");
        } else {
            XB_SPIN(xb_ld(&bar[XB_XGEN(b.x)]) == gen, bar);
            __builtin_amdgcn_fence(__ATOMIC_ACQUIRE, "agent");
            asm volatile("s_waitcnt vmcnt(0)" ::: "memory");
        }
    }
    __syncthreads();
}

constexpr int N_PHASES = 15;
__global__ void __launch_bounds__(NTHR, 2) fwd_kernel(Params p) {
    extern __shared__ __attribute__((aligned(16))) unsigned char lds_raw[];
    LAS unsigned char* lds = (LAS unsigned char*)lds_raw;
    cg::grid_group grid = cg::this_grid();
    unsigned char* ws = p.ws; const int G = gridDim.x, bx = blockIdx.x;
    const float* rstd1 = (const float*)(ws + WS_RSTD1);
#define IN(k) (p.ph_lo <= (k) && (k) < p.ph_hi)
    for (int u_ = threadIdx.x; u_ < 256; u_ += NTHR) ((LAS unsigned*)(lds + 143360))[u_] = 0u;
    __syncthreads();
    XcdBarrier xbar = xcd_barrier_post((unsigned*)(ws + WS_BAR), (volatile LAS unsigned*)(lds + 143360 + 64));
#define SEAM(k) do { if (IN(k) && IN((k) + 1)) { if ((k) == 0) grid.sync(); else xcd_barrier(xbar); } } while (0)
#ifndef PROBE_DUP
#define PROBE_DUP 0
#endif
#define PH(k) if (IN(k)) for (int rep_ = 0; rep_ <= ((PROBE_DUP >> (k)) & 1); ++rep_)
    PH(0) { if (rep_) xcd_barrier(xbar); phase_prologue(p, lds); } SEAM(0);
    PH(1) { if (rep_) xcd_barrier(xbar); pg8::Gemm g{(const bf16*)(ws + WS_XB), (const bf16*)(ws + WS_W_IN), T, N_IN1, DM}; pg8::StaticOrder S; S.init(T, N_IN1, G, bx);
        pg8::EpiIn E{(bf16*)(ws + WS_AU), (bf16*)(ws + WS_AV), (bf16*)(ws + WS_FEAT), (bf16*)(ws + WS_LRAW), rstd1, (float*)(ws + WS_SSQ2)};
        pg8::gemm_phase<pg8::EpiIn, pg8::StaticOrder, true, true>(lds, g, S, E); } SEAM(1);
    PH(2) { if (rep_) xcd_barrier(xbar); phase_gmlp(p, lds); } SEAM(2);
    PH(3) { if (rep_) xcd_barrier(xbar); int kl = K_LORA; asm volatile("" : "+s"(kl)); pg8::Gemm g{(const bf16*)(ws + WS_LIN), (const bf16*)(ws + WS_W_LORA), T, N_LORA, kl}; pg8::StaticOrder S; S.init(T, N_LORA, G, bx);
        pg8::EpiLora E{(float*)(ws + WS_DEC), (bf16*)(ws + WS_AS), (bf16*)(ws + WS_G), p.in[I_W0], p.in[I_A0]};
        pg8::gemm_phase<pg8::EpiLora, pg8::StaticOrder, true, true>(lds, g, S, E); } SEAM(3);
    PH(5) { if (rep_) xcd_barrier(xbar); phase_scan<false>(p, lds); } SEAM(5);
    PH(6) { if (rep_) xcd_barrier(xbar); phase_combine(p, lds); } SEAM(6);
    PH(7) { if (rep_) xcd_barrier(xbar); phase_scan2z(p); } SEAM(7);
    PH(8) { if (rep_) xcd_barrier(xbar);
        { pg8::Gemm g{(const bf16*)(ws + WS_XB), (const bf16*)(ws + WS_W_IN) + (size_t)N_IN1 * DM, T, N_GATE, DM}; pg8::StaticOrder S; S.init(T, N_GATE, G, bx);
          pg8::EpiGate E{(bf16*)p.out, rstd1};
          pg8::gemm_phase<pg8::EpiGate, pg8::StaticOrder, true, true>(lds, g, S, E); }
        { pg8::Gemm g{(const bf16*)(ws + WS_YA), (const bf16*)(ws + WS_W_PA), T, DM, DA}; pg8::StaticOrder S; S.init(T, DM, G, bx);
          pg8::EpiPlain E{(bf16*)(ws + WS_PA)};
          pg8::gemm_phase<pg8::EpiPlain, pg8::StaticOrder, true, true>(lds, g, S, E); } } SEAM(8);
    PH(9) { if (rep_) xcd_barrier(xbar); pg8::Gemm g{(const bf16*)(ws + WS_YB), (const bf16*)(ws + WS_W_PB), T, DM, DB}; pg8::StaticOrder S; S.init(T, DM, G, bx);
        pg8::EpiMerge E{(const bf16*)p.out, (const bf16*)(ws + WS_PA), (bf16*)(ws + WS_MERGED)};
        pg8::gemm_phase<pg8::EpiMerge, pg8::StaticOrder, true, true>(lds, g, S, E); } SEAM(9);
    PH(10) { if (rep_) xcd_barrier(xbar); pg8::Gemm g{(const bf16*)(ws + WS_MERGED), (const bf16*)(ws + WS_W_OUT), T, DM, DM}; pg8::StaticOrder S; S.init(T, DM, G, bx);
        pg8::EpiRes<false> E{(const bf16*)(ws + WS_XB), nullptr, (bf16*)(ws + WS_XB), (float*)(ws + WS_SSQ1)};
        pg8::gemm_phase<pg8::EpiRes<false>, pg8::StaticOrder, true, true>(lds, g, S, E); } SEAM(10);
    PH(11) { if (rep_) xcd_barrier(xbar); pg8::Gemm g{(const bf16*)(ws + WS_XB), (const bf16*)(ws + WS_W_UP), T, 2 * DFF, DM}; pg8::StaticOrder S; S.init(T, 2 * DFF, G, bx);
        pg8::EpiUp E{(bf16*)(ws + WS_ACT), (const float*)(ws + WS_SSQ1), p.in[I_CW], p.in[I_CB], (float*)(ws + WS_TOP), (float*)(ws + WS_BOT), lds + EPI_OFF};
        pg8::gemm_phase<pg8::EpiUp, pg8::StaticOrder, true, true>(lds, g, S, E); } SEAM(11);
    PH(12) { if (rep_) xcd_barrier(xbar); phase_fixup(p); } SEAM(12);
    PH(13) { if (rep_) xcd_barrier(xbar); pg8::Gemm g{(const bf16*)(ws + WS_ACT), (const bf16*)(ws + WS_W_DOWN), T, DM, DFF}; pg8::StaticOrder S; S.init(T, DM, G, bx);
        pg8::EpiRes<true> E{(const bf16*)(ws + WS_XB), p.out, nullptr, (float*)(ws + WS_SSQ2)};
        pg8::gemm_phase<pg8::EpiRes<true>, pg8::StaticOrder, true, true>(lds, g, S, E); } SEAM(13);
    PH(14) { if (rep_) xcd_barrier(xbar); phase_final(p); }
#undef IN
#undef PH
#undef SEAM
}

#ifndef MK_PER_PHASE
#define MK_PER_PHASE 0
#endif
extern "C" void kernel_launch(void* const* d_in, const int* in_sizes, int n_in, void* d_out, int out_size, void* d_ws, size_t ws_size, hipStream_t stream) {
    static int grid = 0;
    if (grid == 0) {
        if (n_in != 27 || out_size != T * DM || ws_size < WS_END) { fprintf(stderr, "kernel_launch: unexpected shapes (n_in %d, out %d, ws %zu < %zu)\n", n_in, out_size, ws_size, (size_t)WS_END); grid = -1; return; }
        int dev = 0, cus = 0, per_cu = 0;
        hipGetDevice(&dev); hipDeviceGetAttribute(&cus, hipDeviceAttributeMultiprocessorCount, dev);
        hipFuncSetAttribute((const void*)fwd_kernel, hipFuncAttributeMaxDynamicSharedMemorySize, LDS_BYTES);
        hipOccupancyMaxActiveBlocksPerMultiprocessor(&per_cu, (const void*)fwd_kernel, NTHR, LDS_BYTES);
        if (per_cu < 1) { fprintf(stderr, "kernel_launch: occupancy query says %d blocks per CU\n", per_cu); per_cu = 1; }
        (void)hipGetLastError();
        grid = cus;
    }
    if (grid < 0) return;
    Params p{};
    for (int i = 0; i < 27; ++i) p.in[i] = (const float*)d_in[i];
    p.out = (float*)d_out; p.ws = (unsigned char*)d_ws;
#if MK_PER_PHASE
    for (int ph = 0; ph < N_PHASES; ++ph) { p.ph_lo = ph; p.ph_hi = ph + 1; hipLaunchKernelGGL(fwd_kernel, dim3(grid), dim3(NTHR), LDS_BYTES, stream, p); }
#else
    p.ph_lo = 0; p.ph_hi = N_PHASES;
    if (hipMemsetAsync((char*)d_ws + WS_BAR, 0, BAR_BYTES, stream) != hipSuccess) { fprintf(stderr, "kernel_launch: memset of barrier words failed\n"); return; }
    void* args[] = {&p};
    hipError_t e = hipLaunchCooperativeKernel((const void*)fwd_kernel, dim3(grid), dim3(NTHR), args, LDS_BYTES, stream);
    if (e != hipSuccess) fprintf(stderr, "cooperative launch failed: %s (grid %d)\n", hipGetErrorString(e), grid);
#endif
}
```
